# Optimizing an MI355X kernel written in HIP

```python
import jax, jax.numpy as jnp
from jax import lax
import numpy as np

D_MODEL = 1024
BATCH = 16
SEQ = 256
DEPTH = 4
DEC_BATCH = 8
DEC_SEQ = 4096
PAST_LEN = 256

GRID_W = 64
N_MIXERS = 2
N_RWKV = (DEPTH + 1) // 2
N_NA = DEPTH // 2
RWKV_HEAD = 64
RWKV_HEADS = D_MODEL // RWKV_HEAD
DECAY_LORA = 64
AAA_LORA = 64
GATE_LORA = 128
NA_HEAD = 64
NA_HEADS = D_MODEL // NA_HEAD
WIN_ROWS = 8
WIN_COLS = 16
Q_COL_BLOCK = 16
K_COL_BAND = 32
N_COL_BLOCKS = GRID_W // Q_COL_BLOCK
D_FF = 4 * D_MODEL
NORM_EPS = 1e-6
GN_EPS = 64e-5
ATTN_SCALE = NA_HEAD ** -0.5
NEG_BIG = -1e30

kernel_name = 'hybrid_rwkv7_natten_diffusion_step'


def rms_norm(x, g):
    x32 = x.astype(jnp.float32)
    y = x32 * lax.rsqrt(jnp.mean(x32 * x32, axis=-1, keepdims=True) + NORM_EPS)
    return (y * g.astype(jnp.float32)).astype(x.dtype)


def ada_mod(cond, w, b):
    m = jax.nn.silu(cond) @ w + b
    return jnp.split(m, 6, axis=-1)


def modulate(x, shift, scale):
    return x * (1 + scale[:, None, :]) + shift[:, None, :]


def sq_relu_mlp(h, w1, w2):
    return jnp.square(jax.nn.relu(h @ w1)) @ w2


def centred_token_shift(x):
    zero = jnp.zeros_like(x[:, :1])
    prev = jnp.concatenate([zero, x[:, :-1]], axis=1)
    nxt = jnp.concatenate([x[:, 1:], zero], axis=1)
    return 0.5 * (prev + nxt)


def delta_rule_scan(r, w, k, v, kk, a, s0, reverse):
    def step(S, inp):
        r_t, w_t, k_t, v_t, kk_t, a_t = inp
        sa = jnp.einsum('bhvk,bhk->bhv', S, -kk_t)
        S_new = (S * w_t[:, :, None, :] + sa[..., None] * (kk_t * a_t)[:, :, None, :]
                 + v_t[..., None] * k_t[:, :, None, :]).astype(S.dtype)
        y = jnp.einsum('bhvk,bhk->bhv', S_new, r_t)
        return S_new, y
    xs = tuple(jnp.moveaxis(t, 1, 0) for t in (r, w, k, v, kk, a))
    S_fin, ys = lax.scan(step, s0, xs, reverse=reverse)
    return jnp.moveaxis(ys, 0, 1), S_fin


def rwkv7_mixer(h, s0, mu, w_rkv, w_o, w0, w1, w2, a0, a1, a2, g1, g2, k_k, k_a, r_k, ln_w, ln_b):
    B, T, D = h.shape
    H, K = RWKV_HEADS, RWKV_HEAD
    delta = centred_token_shift(h) - h
    xs = h[None] + delta[None] * mu[:, None, None, :]
    rkv = jnp.einsum('ibtd,ide->ibte', xs[:3], w_rkv)
    r, k, v = rkv[0], rkv[1], rkv[2]
    xw, xa, xg = xs[3], xs[4], xs[5]
    g = jax.nn.sigmoid(xg @ g1) @ g2
    heads = lambda t: t.reshape(B, T, H, K)
    kk = heads(k * k_k).astype(jnp.float32)
    kk = (kk * lax.rsqrt(jnp.sum(kk * kk, axis=-1, keepdims=True) + 1e-12)).astype(h.dtype)
    r_h, v_h = heads(r), heads(v)
    ys, finals, bonuses = [], [], []
    for d in range(2):
        z = w0[d] + jnp.tanh(xw @ w1[d]) @ w2[d]
        decay = jnp.exp(-jnp.exp(-jax.nn.softplus(-z) - 0.5))
        a = jax.nn.sigmoid(a0[d] + (xa @ a1[d]) @ a2[d])
        k_d = heads(k * (1 + (a - 1) * k_a))
        y_d, s_d = delta_rule_scan(r_h, heads(decay), k_d, v_h, kk, heads(a), s0[:, d], reverse=(d == 1))
        ys.append(y_d)
        finals.append(s_d)
        bonuses.append(jnp.sum(r_h * k_d * r_k, axis=-1, keepdims=True) * v_h)
    y = (ys[0] + ys[1]).astype(jnp.float32)
    mean = jnp.mean(y, axis=-1, keepdims=True)
    var = jnp.mean(jnp.square(y - mean), axis=-1, keepdims=True)
    yn = ((y - mean) * lax.rsqrt(var + GN_EPS)).reshape(B, T, D) * ln_w + ln_b
    o = (yn + (bonuses[0] + bonuses[1]).reshape(B, T, D)) * g
    return o.astype(h.dtype) @ w_o, jnp.stack(finals, axis=1)


def na_qkv(h, w_qkv, q_g, k_g):
    B, T, _ = h.shape
    qkv = (h @ w_qkv).reshape(B, T, 3, NA_HEADS, NA_HEAD)
    q = rms_norm(qkv[:, :, 0], q_g).transpose(0, 2, 1, 3)
    k = rms_norm(qkv[:, :, 1], k_g).transpose(0, 2, 1, 3)
    v = qkv[:, :, 2].transpose(0, 2, 1, 3)
    return q, k, v


def na_context(h, w_qkv, w_o, q_g, k_g):
    B, T, D = h.shape
    q, k, v = na_qkv(h, w_qkv, q_g, k_g)
    s = jnp.einsum('bhqd,bhkd->bhqk', q, k).astype(jnp.float32) * ATTN_SCALE
    p = jax.nn.softmax(s, axis=-1).astype(v.dtype)
    o = jnp.einsum('bhqk,bhkd->bhqd', p, v)
    return o.transpose(0, 2, 1, 3).reshape(B, T, D) @ w_o, k, v


def neighbourhood_tables():
    cb = np.arange(N_COL_BLOCKS)
    band_start = np.clip(cb * Q_COL_BLOCK - WIN_COLS // 2, 0, GRID_W - K_COL_BAND)
    band_idx = band_start[:, None] + np.arange(K_COL_BAND)[None, :]
    q_col = cb[:, None] * Q_COL_BLOCK + np.arange(Q_COL_BLOCK)[None, :]
    win_start = np.clip(q_col - WIN_COLS // 2, 0, GRID_W - WIN_COLS)
    key_col = band_idx[:, None, :]
    valid = (key_col >= win_start[..., None]) & (key_col < win_start[..., None] + WIN_COLS)
    col_off = np.clip(key_col - q_col[..., None] + WIN_COLS - 1, 0, 2 * WIN_COLS - 2)
    return band_idx.astype(np.int32), valid, col_off.astype(np.int32)


def na_latent(h, k_ctx, v_ctx, w_qkv, w_o, q_g, k_g, rpb):
    B, T, D = h.shape
    rows = T // GRID_W
    wr = min(WIN_ROWS, rows)
    q, k, v = na_qkv(h, w_qkv, q_g, k_g)
    grid = lambda t: t.reshape(B, NA_HEADS, rows, GRID_W, NA_HEAD)
    qg, kg, vg = grid(q), grid(k), grid(v)
    band_np, valid_np, col_off_np = neighbourhood_tables()
    band_idx = jnp.asarray(band_np)
    valid = jnp.asarray(valid_np)[:, :, None, :]
    col_off = jnp.asarray(col_off_np)
    n_win = wr * K_COL_BAND

    def row_block(r):
        rs = jnp.clip(r - WIN_ROWS // 2, 0, rows - wr)
        q_r = lax.dynamic_index_in_dim(qg, r, axis=2, keepdims=False).reshape(
            B, NA_HEADS, N_COL_BLOCKS, Q_COL_BLOCK, NA_HEAD)
        k_r = jnp.take(lax.dynamic_slice_in_dim(kg, rs, wr, axis=2), band_idx, axis=3)
        v_r = jnp.take(lax.dynamic_slice_in_dim(vg, rs, wr, axis=2), band_idx, axis=3)
        row_off = rs + jnp.arange(wr) - r + WIN_ROWS - 1
        bias = jnp.take(jnp.take(rpb, row_off, axis=1), col_off, axis=2)
        bias = bias.transpose(0, 2, 3, 1, 4).astype(jnp.float32)
        s_win = jnp.einsum('bhnqd,bhrnkd->bhnqrk', q_r, k_r).astype(jnp.float32) * ATTN_SCALE + bias
        s_win = jnp.where(valid, s_win, NEG_BIG)
        s_ctx = jnp.einsum('bhnqd,bhld->bhnql', q_r, k_ctx).astype(jnp.float32) * ATTN_SCALE
        s = jnp.concatenate([s_win.reshape(B, NA_HEADS, N_COL_BLOCKS, Q_COL_BLOCK, n_win), s_ctx], axis=-1)
        p = jax.nn.softmax(s, axis=-1).astype(v.dtype)
        p_win = p[..., :n_win].reshape(B, NA_HEADS, N_COL_BLOCKS, Q_COL_BLOCK, wr, K_COL_BAND)
        p_ctx = p[..., n_win:]
        o = (jnp.einsum('bhnqrk,bhrnkd->bhnqd', p_win, v_r)
             + jnp.einsum('bhnql,bhld->bhnqd', p_ctx, v_ctx))
        return o.reshape(B, NA_HEADS, GRID_W, NA_HEAD)

    o = lax.map(row_block, jnp.arange(rows))
    o = o.transpose(1, 0, 3, 2, 4).reshape(B, T, D)
    return o @ w_o


def setup_inputs(seed: int = 0) -> dict:
    key = jax.random.key(seed)
    ks = iter(jax.random.split(key, 40))
    nrm = lambda shape, scale: jax.random.normal(next(ks), shape, jnp.float32) * scale
    D, H, K = D_MODEL, RWKV_HEADS, RWKV_HEAD
    return {
        'x_prompt': nrm((BATCH, SEQ, D), 1.0),
        'x_sample': nrm((DEC_BATCH, DEC_SEQ, D), 1.0),
        'state_rwkv': nrm((DEC_BATCH, N_RWKV, 2, H, K, K), 0.5),
        'cache_na_k': nrm((DEC_BATCH, N_NA, NA_HEADS, PAST_LEN, NA_HEAD), 1.0),
        'cache_na_v': nrm((DEC_BATCH, N_NA, NA_HEADS, PAST_LEN, NA_HEAD), 1.0),
        'c': nrm((DEC_BATCH, D), 1.0),
        'c_ctx': nrm((D,), 1.0),
        'norm_g': 1.0 + nrm((DEPTH, 2, D), 0.02),
        'ada_w': nrm((DEPTH, D, 6 * D), 0.3 * D ** -0.5),
        'ada_b': nrm((DEPTH, 6 * D), 0.02),
        'mlp_w1': nrm((DEPTH, D, D_FF), D ** -0.5),
        'mlp_w2': nrm((DEPTH, D_FF, D), D_FF ** -0.5),
        'rwkv_mu': jax.random.uniform(next(ks), (N_RWKV, 6, D), jnp.float32),
        'rwkv_w_rkv': nrm((N_RWKV, 3, D, D), D ** -0.5),
        'rwkv_w_o': nrm((N_RWKV, D, D), D ** -0.5),
        'rwkv_w0': nrm((N_RWKV, 2, D), 0.5),
        'rwkv_w1': nrm((N_RWKV, 2, D, DECAY_LORA), D ** -0.5),
        'rwkv_w2': nrm((N_RWKV, 2, DECAY_LORA, D), 0.3 * DECAY_LORA ** -0.5),
        'rwkv_a0': nrm((N_RWKV, 2, D), 0.1),
        'rwkv_a1': nrm((N_RWKV, 2, D, AAA_LORA), D ** -0.5),
        'rwkv_a2': nrm((N_RWKV, 2, AAA_LORA, D), 0.3 * AAA_LORA ** -0.5),
        'rwkv_g1': nrm((N_RWKV, D, GATE_LORA), D ** -0.5),
        'rwkv_g2': nrm((N_RWKV, GATE_LORA, D), GATE_LORA ** -0.5),
        'rwkv_k_k': 0.85 + nrm((N_RWKV, D), 0.02),
        'rwkv_k_a': 1.0 + nrm((N_RWKV, D), 0.02),
        'rwkv_r_k': nrm((N_RWKV, H, K), 0.1),
        'rwkv_ln_w': 1.0 + nrm((N_RWKV, D), 0.02),
        'rwkv_ln_b': nrm((N_RWKV, D), 0.02),
        'na_w_qkv': nrm((N_NA, D, 3 * D), D ** -0.5),
        'na_w_o': nrm((N_NA, D, D), D ** -0.5),
        'na_q_g': 1.0 + nrm((N_NA, NA_HEAD), 0.02),
        'na_k_g': 1.0 + nrm((N_NA, NA_HEAD), 0.02),
        'na_rpb': nrm((N_NA, NA_HEADS, 2 * WIN_ROWS - 1, 2 * WIN_COLS - 1), 0.1),
    }


def reference(x_prompt, x_sample, state_rwkv, cache_na_k, cache_na_v, c, c_ctx,
              norm_g, ada_w, ada_b, mlp_w1, mlp_w2,
              rwkv_mu, rwkv_w_rkv, rwkv_w_o, rwkv_w0, rwkv_w1, rwkv_w2, rwkv_a0, rwkv_a1, rwkv_a2,
              rwkv_g1, rwkv_g2, rwkv_k_k, rwkv_k_a, rwkv_r_k, rwkv_ln_w, rwkv_ln_b,
              na_w_qkv, na_w_o, na_q_g, na_k_g, na_rpb):
    rwkv_params = (rwkv_mu, rwkv_w_rkv, rwkv_w_o, rwkv_w0, rwkv_w1, rwkv_w2, rwkv_a0, rwkv_a1, rwkv_a2,
                   rwkv_g1, rwkv_g2, rwkv_k_k, rwkv_k_a, rwkv_r_k, rwkv_ln_w, rwkv_ln_b)

    xp = x_prompt
    bp = x_prompt.shape[0]
    new_states, new_k, new_v = [], [], []
    for l in range(DEPTH):
        i = l // N_MIXERS
        sh1, sc1, gt1, sh2, sc2, gt2 = ada_mod(c_ctx[None, :], ada_w[l], ada_b[l])
        h = modulate(rms_norm(xp, norm_g[l, 0]), sh1, sc1)
        if l % N_MIXERS == 0:
            s0 = jnp.zeros((bp, 2, RWKV_HEADS, RWKV_HEAD, RWKV_HEAD), xp.dtype)
            o, s_fin = rwkv7_mixer(h, s0, *[p[i] for p in rwkv_params])
            new_states.append(s_fin)
        else:
            o, k_c, v_c = na_context(h, na_w_qkv[i], na_w_o[i], na_q_g[i], na_k_g[i])
            new_k.append(k_c)
            new_v.append(v_c)
        xp = xp + gt1[:, None, :] * o
        h = modulate(rms_norm(xp, norm_g[l, 1]), sh2, sc2)
        xp = xp + gt2[:, None, :] * sq_relu_mlp(h, mlp_w1[l], mlp_w2[l])
    y_prompt = xp

    xs = x_sample
    for l in range(DEPTH):
        i = l // N_MIXERS
        sh1, sc1, gt1, sh2, sc2, gt2 = ada_mod(c, ada_w[l], ada_b[l])
        h = modulate(rms_norm(xs, norm_g[l, 0]), sh1, sc1)
        if l % N_MIXERS == 0:
            o, _ = rwkv7_mixer(h, state_rwkv[:, i], *[p[i] for p in rwkv_params])
        else:
            o = na_latent(h, cache_na_k[:, i], cache_na_v[:, i], na_w_qkv[i], na_w_o[i],
                          na_q_g[i], na_k_g[i], na_rpb[i])
        xs = xs + gt1[:, None, :] * o
        h = modulate(rms_norm(xs, norm_g[l, 1]), sh2, sc2)
        xs = xs + gt2[:, None, :] * sq_relu_mlp(h, mlp_w1[l], mlp_w2[l])
    y_sample = xs

    new_state_rwkv = jnp.stack(new_states, axis=1)
    new_cache_na_k = jnp.stack(new_k, axis=1)
    new_cache_na_v = jnp.stack(new_v, axis=1)
    return (y_prompt, y_sample, new_state_rwkv, new_cache_na_k, new_cache_na_v)
```

```cpp
#include <hip/hip_runtime.h>
#include <hip/hip_cooperative_groups.h>
#include <cstdio>
#include <cstdint>
namespace cg = cooperative_groups;

#define LAS __attribute__((address_space(3)))
typedef unsigned short bf16_t;
typedef short bf16x8 __attribute__((ext_vector_type(8)));
typedef float f32x4 __attribute__((ext_vector_type(4)));
typedef unsigned u32x4 __attribute__((ext_vector_type(4)));
typedef unsigned u32x2 __attribute__((ext_vector_type(2)));

#ifndef REP_GEMM
#define REP_GEMM 1
#endif
#ifndef REP_SCAN
#define REP_SCAN 1
#endif
#ifndef REP_ATTN
#define REP_ATTN 1
#endif
#ifndef REP_ELT
#define REP_ELT 1
#endif
#ifndef REP_SYNC
#define REP_SYNC 1
#endif
#ifndef MK_N_LAUNCH_PER_PHASE
#define MK_N_LAUNCH_PER_PHASE 0
#endif

constexpr int D = 1024, MTOK = 36864, MCTX = 4096, NCOND = 9, FF = 4096;
constexpr int NTHR = 512, NWAVES = 8;
constexpr size_t MiB = 1u << 20;
constexpr size_t O_STATE = 37748736, O_CK = 41943040, O_CV = 50331648;
constexpr size_t WS_MODV = 0;
constexpr size_t WS_CS = 1 * MiB;
constexpr size_t WS_WT = 6 * MiB;
constexpr size_t WS_ACT = 40 * MiB;
constexpr size_t TOKK = (size_t)MTOK * 1024;
constexpr size_t WS_END = WS_ACT + 13 * TOKK;
constexpr size_t WT_CAT = 0, WT_G2 = 14 * MiB, WT_W2S = 14 * MiB + 512 * 1024, WT_A2S = 14 * MiB + 768 * 1024, WT_WO = 15 * MiB, WT_W1 = 17 * MiB, WT_W2 = 25 * MiB;
constexpr size_t WT_QKV = 0;
constexpr size_t A_RKVL = 0, A_H2 = 7 * TOKK, A_G = 11 * TOKK;
constexpr size_t A_HN = 0, A_U = 2 * TOKK;
constexpr size_t A_QK = 2 * TOKK, A_VT = 6 * TOKK, A_CKB = 10 * TOKK, A_CVT = 10 * TOKK + 4 * MiB;
constexpr int LDR = 3584;
constexpr int LDS_BYTES = 147456;
constexpr int TAB_OFF = 146944;

__device__ __forceinline__ unsigned cvt_pk_bf16(float lo, float hi) { unsigned r; asm volatile("v_cvt_pk_bf16_f32 %0, %1, %2" : "=v"(r) : "v"(lo), "v"(hi)); return r; }
__device__ __forceinline__ float bf_lo(unsigned u) { return __uint_as_float(u << 16); }
__device__ __forceinline__ float bf_hi(unsigned u) { return __uint_as_float(u & 0xffff0000u); }
__device__ __forceinline__ float wave_sum(float v) {
#pragma unroll
    for (int o = 1; o < 64; o <<= 1) v += __shfl_xor(v, o);
    return v;
}
__device__ __forceinline__ float dpp_xor1(float x) { return __builtin_bit_cast(float, __builtin_amdgcn_update_dpp(0, __builtin_bit_cast(int, x), 0xB1, 0xF, 0xF, true)); }
__device__ __forceinline__ float dpp_xor2(float x) { return __builtin_bit_cast(float, __builtin_amdgcn_update_dpp(0, __builtin_bit_cast(int, x), 0x4E, 0xF, 0xF, true)); }
__device__ __forceinline__ float quad_sum(float x) { x += dpp_xor1(x); x += dpp_xor2(x); return x; }
__device__ __forceinline__ float dpp_hmirror(float x) { return __builtin_bit_cast(float, __builtin_amdgcn_update_dpp(0, __builtin_bit_cast(int, x), 0x141, 0xF, 0xF, true)); }
__device__ __forceinline__ float oct_sum(float x) { x += dpp_hmirror(x); x += dpp_xor1(x); x += dpp_xor2(x); return x; }
typedef float f32x2 __attribute__((ext_vector_type(2)));
template <int SH> __device__ __forceinline__ float dpp_row_shr_or1(float x) {
    return __builtin_bit_cast(float, __builtin_amdgcn_update_dpp(0x3f800000, __builtin_bit_cast(int, x), 0x110 + SH, 0xF, 0xF, false)); }
__device__ __forceinline__ float sigmoidf_(float x) { return __builtin_amdgcn_rcpf(1.0f + __expf(-x)); }
__device__ __forceinline__ float tanhf_(float x) { return 1.0f - 2.0f * __builtin_amdgcn_rcpf(1.0f + __expf(2.0f * x)); }
__device__ __forceinline__ int cond_of_row(int row) { return row < MCTX ? 0 : 1 + ((row - MCTX) >> 12); }

namespace pg8 {
constexpr int BM = 256, BK = 64, HALF = 128, HTB = HALF * BK * 2, STAGE_BYTES = 8 * HTB, NXCD = 8, WGM = 4;
__host__ __device__ __forceinline__ int lds_byte(int r, int c) { const int st = (r >> 4) * 2 + (c >> 5), rr = r & 15, cc = c & 31, ob = rr * 64 + cc * 2; return st * 1024 + (ob ^ (((ob >> 9) & 1) << 5)); }
__host__ __device__ __forceinline__ void stage_rc(int b, int& R, int& C) { const int st = b / 1024, sb = b % 1024, swz = sb ^ (((sb >> 9) & 1) << 5); R = (st >> 1) * 16 + swz / 64; C = (st & 1) * 32 + (swz % 64) / 2; }
struct Unit { int pm, pn; };
struct Gemm { const bf16_t* A; int lda; const bf16_t* Bt; int N, K; };
struct StaticOrder {
    int nM, nN, nwg, G, c, wgm;
    __device__ void init(int M, int N, int G_, int c_, int wgm_ = WGM) { nM = M / BM; nN = N / BM; nwg = nM * nN; G = G_; c = c_; wgm = wgm_; }
    __device__ bool next(int i, Unit& u) const {
        const long L = (long)i * G + c; if (L >= nwg) return false;
        int wgid = (int)L; { const int q = nwg / NXCD, r = nwg % NXCD, xcd = wgid % NXCD, off = wgid / NXCD; wgid = (xcd < r ? xcd * (q + 1) : r * (q + 1) + (xcd - r) * q) + off; }
        const int nig = wgm * nN, gid = wgid / nig, fm = gid * wgm, gsz = (nM - fm) < wgm ? (nM - fm) : wgm;
        u.pm = fm + ((wgid % nig) % gsz); u.pn = (wgid % nig) / gsz; return true;
    }
};
template <class Epi>
__device__ __forceinline__ void gemm_phase(LAS unsigned char* lds, const int tid, const Gemm g, const StaticOrder& S, const Epi& E) {
    const int wid = __builtin_amdgcn_readfirstlane(tid >> 6), lane = tid & 63, wr = wid >> 2, wc = wid & 3, fr = lane & 15, fq = lane >> 4;
    const int K = g.K, nt = K / BK, lda = g.lda;
    unsigned voffA[2], voffB[2];
#pragma unroll
    for (int i = 0; i < 2; ++i) { int R, C; stage_rc(tid * 16 + i * 8192, R, C); const int r32 = R & 31;
        const int Rb = 64 * (R >> 5) + (Epi::PERM ? (8 * ((r32 & 15) >> 2) + 4 * (r32 >> 4) + (r32 & 3)) : r32);
        voffA[i] = (unsigned)(R * lda + C) * 2u; voffB[i] = (unsigned)(Rb * K + C) * 2u; }
    const size_t kstep = (size_t)(BK * 2);
    const size_t hstepA = (size_t)HALF * lda * 2, tstepA = 2 * hstepA;
    const size_t hstepB = (size_t)32 * K * 2, tstepB = (size_t)256 * K * 2;
    const unsigned ldsw = (unsigned)wid * 1024u;
    const int aoff = lds_byte(wr * 64 + fr, fq * 8), boff = lds_byte(wc * 32 + fr, fq * 8);
#define PG8_SA(b, h) (((b) * 2 + (h)) * HTB)
#define PG8_SB(b, h) ((4 + (b) * 2 + (h)) * HTB)
#define PG8_STAGE(bufoff, gbase, voff) do { _Pragma("unroll") for (int _i = 0; _i < 2; ++_i) \
        __builtin_amdgcn_global_load_lds((const unsigned*)((const char*)(gbase) + (voff)[_i]), (LAS unsigned*)(lds + (bufoff) + ldsw + _i * 8192), 16, 0, 0); } while (0)
#define PG8_LDA(dst, b, h) do { _Pragma("unroll") for (int m = 0; m < 4; ++m) _Pragma("unroll") for (int k = 0; k < 2; ++k) dst[m][k] = *(const LAS bf16x8*)(lds + PG8_SA(b, h) + aoff + m * 2048 + k * 1024); } while (0)
#define PG8_LDB(dst, b, h) do { _Pragma("unroll") for (int n = 0; n < 2; ++n) _Pragma("unroll") for (int k = 0; k < 2; ++k) dst[n][k] = *(const LAS bf16x8*)(lds + PG8_SB(b, h) + boff + n * 2048 + k * 1024); } while (0)
#define PG8_MMA(ai, bj, At, Bt) do { __builtin_amdgcn_s_setprio(1); _Pragma("unroll") for (int m = 0; m < 4; ++m) _Pragma("unroll") for (int n = 0; n < 2; ++n) _Pragma("unroll") for (int k = 0; k < 2; ++k) \
        acc[ai][bj][m][n] = __builtin_amdgcn_mfma_f32_16x16x32_bf16(Bt[n][k], At[m][k], acc[ai][bj][m][n], 0, 0, 0); __builtin_amdgcn_s_setprio(0); } while (0)
#define PG8_WAIT_V(n) asm volatile("s_waitcnt vmcnt(" #n ")" ::: "memory")
#define PG8_WAIT_L(n) asm volatile("s_waitcnt lgkmcnt(" #n ")" ::: "memory")
#define PG8_BAR __builtin_amdgcn_s_barrier()
#define PG8_SCHED __builtin_amdgcn_sched_barrier(0)
    Unit cur, nxt; int ui = 0;
    if (!S.next(0, cur)) return;
    f32x4 acc[2][2][4][2];
#pragma unroll
    for (int a = 0; a < 2; ++a)
#pragma unroll
        for (int b = 0; b < 2; ++b)
#pragma unroll
            for (int m = 0; m < 4; ++m)
#pragma unroll
                for (int n = 0; n < 2; ++n) acc[a][b][m][n] = (f32x4){0.f, 0.f, 0.f, 0.f};
    bf16x8 At[4][2], B0[2][2], B1[2][2];
    const char* cA = (const char*)g.A + (size_t)cur.pm * tstepA; const char* cB = (const char*)g.Bt + (size_t)cur.pn * tstepB;
    PG8_STAGE(PG8_SB(0, 0), cB, voffB); PG8_STAGE(PG8_SB(0, 1), cB + hstepB, voffB); PG8_STAGE(PG8_SA(0, 0), cA, voffA); PG8_STAGE(PG8_SA(0, 1), cA + hstepA, voffA);
    if (wr == 1) PG8_BAR;
    PG8_WAIT_V(2); PG8_BAR;
    PG8_STAGE(PG8_SB(1, 0), cB + kstep, voffB); PG8_STAGE(PG8_SA(1, 0), cA + kstep, voffA); PG8_STAGE(PG8_SB(1, 1), cB + hstepB + kstep, voffB);
    PG8_WAIT_V(6); PG8_BAR;
    for (;;) {
        const bool has_next = S.next(ui + 1, nxt);
        const char* nA = has_next ? (const char*)g.A + (size_t)nxt.pm * tstepA : cA; const char* nB = has_next ? (const char*)g.Bt + (size_t)nxt.pn * tstepB : cB;
        for (int t = 0; t < nt; t += 2) {
            const bool last = (t == nt - 2);
            const char* a1 = cA + (size_t)(t + 1) * kstep;
            const char* a2 = last ? nA : cA + (size_t)(t + 2) * kstep; const char* b2 = last ? nB : cB + (size_t)(t + 2) * kstep;
            const char* a3 = a2 + kstep; const char* b3 = b2 + kstep;
            PG8_LDB(B0, 0, 0); PG8_LDB(B1, 0, 1); PG8_SCHED; PG8_LDA(At, 0, 0); PG8_STAGE(PG8_SA(1, 1), a1 + hstepA, voffA);
            PG8_WAIT_V(8); PG8_WAIT_L(0); PG8_BAR; PG8_MMA(0, 0, At, B0); PG8_MMA(0, 1, At, B1); PG8_BAR; PG8_SCHED;
            PG8_LDA(At, 0, 1); PG8_STAGE(PG8_SB(0, 0), b2, voffB); PG8_STAGE(PG8_SB(0, 1), b2 + hstepB, voffB); PG8_STAGE(PG8_SA(0, 0), a2, voffA);
            PG8_WAIT_V(8); PG8_WAIT_L(0); PG8_BAR; PG8_MMA(1, 0, At, B0); PG8_MMA(1, 1, At, B1); PG8_BAR; PG8_SCHED;
            PG8_LDB(B0, 1, 0); PG8_LDB(B1, 1, 1); PG8_SCHED; PG8_LDA(At, 1, 0); PG8_STAGE(PG8_SA(0, 1), a2 + hstepA, voffA);
            PG8_WAIT_V(8); PG8_WAIT_L(0); PG8_BAR; PG8_MMA(0, 0, At, B0); PG8_MMA(0, 1, At, B1); PG8_BAR; PG8_SCHED;
            PG8_LDA(At, 1, 1); PG8_STAGE(PG8_SB(1, 0), b3, voffB); PG8_STAGE(PG8_SB(1, 1), b3 + hstepB, voffB); PG8_STAGE(PG8_SA(1, 0), a3, voffA);
            PG8_WAIT_V(8); PG8_WAIT_L(0); PG8_BAR; PG8_MMA(1, 0, At, B0); PG8_MMA(1, 1, At, B1); PG8_BAR; PG8_SCHED;
        }
        if (wr == 0) PG8_BAR;
        E(acc, cur, wr, wc, fr, fq);
        if (!has_next) break;
#pragma unroll
        for (int a = 0; a < 2; ++a)
#pragma unroll
            for (int b = 0; b < 2; ++b)
#pragma unroll
                for (int m = 0; m < 4; ++m)
#pragma unroll
                    for (int n = 0; n < 2; ++n) acc[a][b][m][n] = (f32x4){0.f, 0.f, 0.f, 0.f};
        cur = nxt; cA = nA; cB = nB; ++ui;
        if (wr == 1) PG8_BAR;
    }
    PG8_WAIT_V(0);
    PG8_BAR;
#undef PG8_SA
#undef PG8_SB
#undef PG8_STAGE
#undef PG8_LDA
#undef PG8_LDB
#undef PG8_MMA
#undef PG8_WAIT_V
#undef PG8_WAIT_L
#undef PG8_BAR
#undef PG8_SCHED
}

typedef f32x4 Acc[2][2][4][2];
struct EpiRKVL {
    static constexpr bool PERM = true;
    bf16_t* O; const float* kkg;
    __device__ __forceinline__ void operator()(const Acc& acc, const Unit& u, int wr, int wc, int fr, int fq) const {
        const int act = (u.pn == 12 && wc < 2) ? 1 : ((u.pn == 13 && wc < 2) ? 2 : 0);
        if (u.pn == 13 && wc >= 2) return;
        const int row0 = u.pm * BM + wr * 64 + fr, col0 = u.pn * BM + wc * 64 + 8 * fq;
        if (u.pn >= 4 && u.pn < 8) {
            const int hh = ((u.pn - 4) << 2) + wc; const float* gq = kkg + hh * 64 + 8 * fq;
            f32x4 kg[2][2];
#pragma unroll
            for (int bj = 0; bj < 2; ++bj)
#pragma unroll
                for (int n = 0; n < 2; ++n) kg[bj][n] = *(const f32x4*)(gq + bj * 32 + n * 4);
#pragma unroll
            for (int ai = 0; ai < 2; ++ai)
#pragma unroll
                for (int m = 0; m < 4; ++m) { float ss = 0.f;
#pragma unroll
                    for (int bj = 0; bj < 2; ++bj)
#pragma unroll
                        for (int n = 0; n < 2; ++n) { const f32x4 v = acc[ai][bj][m][n] * kg[bj][n]; ss += (v[0] * v[0] + v[1] * v[1]) + (v[2] * v[2] + v[3] * v[3]); }
                    ss += __shfl_xor(ss, 16); ss += __shfl_xor(ss, 32);
                    if (fq == 0) ((float*)(O + (size_t)(row0 + ai * HALF + m * 16) * LDR + 3456))[hh] = __builtin_amdgcn_rcpf(ss + 1e-12f); }
        }
#pragma unroll
        for (int ai = 0; ai < 2; ++ai)
#pragma unroll
            for (int m = 0; m < 4; ++m) { bf16_t* rowp = O + (size_t)(row0 + ai * HALF + m * 16) * LDR + col0;
#pragma unroll
                for (int bj = 0; bj < 2; ++bj) { u32x4 w;
#pragma unroll
                    for (int n = 0; n < 2; ++n) { f32x4 v = acc[ai][bj][m][n];
                        if (act == 1) { v[0] = tanhf_(v[0]); v[1] = tanhf_(v[1]); v[2] = tanhf_(v[2]); v[3] = tanhf_(v[3]); }
                        if (act == 2) { v[0] = sigmoidf_(v[0]); v[1] = sigmoidf_(v[1]); v[2] = sigmoidf_(v[2]); v[3] = sigmoidf_(v[3]); }
                        w[2 * n] = cvt_pk_bf16(v[0], v[1]); w[2 * n + 1] = cvt_pk_bf16(v[2], v[3]); }
                    *(u32x4*)(rowp + bj * 32) = w; } }
    }
};
template <int ACT> struct EpiBf16 {
    static constexpr bool PERM = true;
    bf16_t* O; int ldc;
    __device__ __forceinline__ void operator()(const Acc& acc, const Unit& u, int wr, int wc, int fr, int fq) const {
        const int row0 = u.pm * BM + wr * 64 + fr, col0 = u.pn * BM + wc * 64 + 8 * fq;
#pragma unroll
        for (int ai = 0; ai < 2; ++ai)
#pragma unroll
            for (int m = 0; m < 4; ++m) { bf16_t* rowp = O + (size_t)(row0 + ai * HALF + m * 16) * ldc + col0;
#pragma unroll
                for (int bj = 0; bj < 2; ++bj) { u32x4 w;
#pragma unroll
                    for (int n = 0; n < 2; ++n) { f32x4 v = acc[ai][bj][m][n];
                        if (ACT == 1) { v[0] = fmaxf(v[0], 0.f); v[1] = fmaxf(v[1], 0.f); v[2] = fmaxf(v[2], 0.f); v[3] = fmaxf(v[3], 0.f); v = v * v; }
                        w[2 * n] = cvt_pk_bf16(v[0], v[1]); w[2 * n + 1] = cvt_pk_bf16(v[2], v[3]); }
                    *(u32x4*)(rowp + bj * 32) = w; } }
    }
};
template <bool FIRST> struct EpiRes {
    static constexpr bool PERM = false;
    float* X; const float* gate; float gs; LAS unsigned char* tab;
    __device__ __forceinline__ void operator()(const Acc& acc, const Unit& u, int wr, int wc, int fr, int fq) const {
        const int cond = u.pm < 16 ? 0 : 1 + ((u.pm - 16) >> 4);
        const int row0 = u.pm * BM + wr * 64 + fr, col0 = u.pn * BM + wc * 64 + 4 * fq;
        const float* gp = gate + (size_t)cond * 6144 + col0;
        f32x4 gv[2][2];
#pragma unroll
        for (int bj = 0; bj < 2; ++bj)
#pragma unroll
            for (int n = 0; n < 2; ++n) gv[bj][n] = *(const f32x4*)(gp + bj * 32 + n * 16) * gs;
#pragma unroll
        for (int ai = 0; ai < 2; ++ai)
#pragma unroll
            for (int m = 0; m < 4; ++m) { const size_t ro = (size_t)(row0 + ai * HALF + m * 16) * D + col0; float* rowp = X + ro;
                const float* srcp = rowp;
                if (FIRST) { const LAS unsigned* t = (const LAS unsigned*)tab + (u.pm < 16 ? 0 : 2); const unsigned lo = __builtin_amdgcn_readfirstlane(t[0]), hi = __builtin_amdgcn_readfirstlane(t[1]);
                    srcp = (const float*)(__attribute__((address_space(1))) const unsigned char*)(((unsigned long long)hi << 32) | lo) + (u.pm < 16 ? ro : ro - (size_t)MCTX * D); }
#pragma unroll
                for (int bj = 0; bj < 2; ++bj)
#pragma unroll
                    for (int n = 0; n < 2; ++n) { f32x4 x = *(const f32x4*)(srcp + bj * 32 + n * 16); x = x + gv[bj][n] * acc[ai][bj][m][n]; *(f32x4*)(rowp + bj * 32 + n * 16) = x; }
                asm volatile("" ::: "memory"); }
    }
};
struct EpiQKV {
    static constexpr bool PERM = true;
    bf16_t* QK; bf16_t* VT; const float* qg; const float* kg; float* out_k; float* out_v; int li;
    __device__ __forceinline__ void operator()(const Acc& acc, const Unit& u, int wr, int wc, int fr, int fq) const {
        const int which = u.pn >> 2, hh = ((u.pn & 3) << 2) + wc;
        const int row0 = u.pm * BM + wr * 64 + fr;
        const bool ctx = u.pm < 16;
        if (which < 2) {
            const float* gp = (which == 0 ? qg : kg) + 8 * fq;
            f32x4 gv[2][2];
#pragma unroll
            for (int bj = 0; bj < 2; ++bj)
#pragma unroll
                for (int n = 0; n < 2; ++n) gv[bj][n] = *(const f32x4*)(gp + bj * 32 + n * 4);
#pragma unroll
            for (int ai = 0; ai < 2; ++ai)
#pragma unroll
                for (int m = 0; m < 4; ++m) {
                    float ss = 0.f;
#pragma unroll
                    for (int bj = 0; bj < 2; ++bj)
#pragma unroll
                        for (int n = 0; n < 2; ++n) { const f32x4 v = acc[ai][bj][m][n]; ss += (v[0] * v[0] + v[1] * v[1]) + (v[2] * v[2] + v[3] * v[3]); }
                    ss += __shfl_xor(ss, 16); ss += __shfl_xor(ss, 32);
                    const float rinv = rsqrtf(ss * (1.0f / 64.0f) + 1e-6f);
                    const int row = row0 + ai * HALF + m * 16;
                    bf16_t* rowp = QK + (size_t)row * 2048 + which * 1024 + hh * 64 + 8 * fq;
                    float* op = out_k + ((size_t)((u.pm * 2 + li) * 16 + hh) * 256 + (row & 255)) * 64 + 8 * fq;
#pragma unroll
                    for (int bj = 0; bj < 2; ++bj) { u32x4 w;
#pragma unroll
                        for (int n = 0; n < 2; ++n) { f32x4 v = acc[ai][bj][m][n] * rinv * gv[bj][n];
                            w[2 * n] = cvt_pk_bf16(v[0], v[1]); w[2 * n + 1] = cvt_pk_bf16(v[2], v[3]);
                            if (which == 1 && ctx) *(f32x4*)(op + bj * 32 + n * 4) = v; }
                        *(u32x4*)(rowp + bj * 32) = w; }
                }
        } else {
#pragma unroll
            for (int ai = 0; ai < 2; ++ai)
#pragma unroll
                for (int m = 0; m < 4; ++m) {
                    const int row = row0 + ai * HALF + m * 16;
                    float* op = out_v + ((size_t)((u.pm * 2 + li) * 16 + hh) * 256 + (row & 255)) * 64 + 8 * fq;
#pragma unroll
                    for (int bj = 0; bj < 2; ++bj)
#pragma unroll
                        for (int n = 0; n < 2; ++n) { const f32x4 v = acc[ai][bj][m][n];
                            const unsigned w0 = cvt_pk_bf16(v[0], v[1]), w1 = cvt_pk_bf16(v[2], v[3]);
                            const bool odd = fr & 1; const unsigned snd = odd ? w0 : w1;
                            const unsigned rcv = (unsigned)__builtin_amdgcn_update_dpp(0, (int)snd, 0xB1, 0xF, 0xF, true);
                            const unsigned mine = odd ? w1 : w0;
                            const unsigned lo = odd ? ((rcv & 0xffffu) | (mine << 16)) : ((mine & 0xffffu) | (rcv << 16));
                            const unsigned hi = odd ? ((rcv >> 16) | (mine & 0xffff0000u)) : ((mine >> 16) | (rcv & 0xffff0000u));
                            unsigned* vp = (unsigned*)(VT + (size_t)(hh * 64 + bj * 32 + 8 * fq + 4 * n + (odd ? 2 : 0)) * MTOK + (row & ~1));
                            vp[0] = lo; *(unsigned*)((bf16_t*)vp + MTOK) = hi;
                            if (ctx) *(f32x4*)(op + bj * 32 + n * 4) = v; }
                }
        }
    }
};
}

struct Args { const float* in[33]; float* out; unsigned char* ws; int lo, hi; };

struct Frame {
    LAS unsigned char* lds;
    int tid, lane, wave, G, bid;
    mutable int rot;
    int cbid, cG;
    float* out; unsigned char* ws;
};

__device__ __forceinline__ const float* IN(const Frame& F, int k) {
    const LAS unsigned* t = (const LAS unsigned*)(F.lds + TAB_OFF) + 2 * k; unsigned lo = t[0], hi = t[1];
    lo = __builtin_amdgcn_readfirstlane(lo); hi = __builtin_amdgcn_readfirstlane(hi); return (const float*)(__attribute__((address_space(1))) const unsigned char*)(((unsigned long long)hi << 32) | lo);
}
__device__ __forceinline__ void conv_t(const Frame& F, const float* W0, int K, int N, bf16_t* dst0, int ldd, int dcol0, const float* scale, int nbatch = 1, size_t sstride = 0, size_t dstride = 0) {
    LAS float* scr = (LAS float*)(F.lds + F.wave * 8704);
    const int lane = F.lane, NGW = F.cG * NWAVES;
    const int nblk = N / 32, nitems1 = (K / 64) * nblk, nitems = nitems1 * nbatch;
    int gw = F.cbid * NWAVES + F.wave - F.rot; if (gw < 0) gw += NGW;
    F.rot = (F.rot + nitems) % NGW;
    for (int it0 = gw; it0 < nitems; it0 += NGW) {
        const int bt = it0 / nitems1, it = it0 % nitems1; const float* W = W0 + (size_t)bt * sstride; bf16_t* dst = dst0 + (size_t)bt * dstride;
        const int kb = it / nblk, nb = it % nblk, k0 = 64 * kb, n0 = 32 * nb;
#pragma unroll 8
        for (int i = 0; i < 32; ++i) { const int kk = 2 * i + (lane >> 5); float v = W[(size_t)(k0 + kk) * N + n0 + (lane & 31)]; if (scale) v *= scale[k0 + kk]; scr[kk * 33 + (lane & 31)] = v; }
        asm volatile("s_waitcnt lgkmcnt(0)" ::: "memory");
        const int c = lane & 7;
#pragma unroll
        for (int j = 0; j < 4; ++j) { const int n = (lane >> 3) + 8 * j; const LAS float* s = scr + (8 * c) * 33 + n;
            u32x4 o; o.x = cvt_pk_bf16(s[0 * 33], s[1 * 33]); o.y = cvt_pk_bf16(s[2 * 33], s[3 * 33]); o.z = cvt_pk_bf16(s[4 * 33], s[5 * 33]); o.w = cvt_pk_bf16(s[6 * 33], s[7 * 33]);
            *(u32x4*)(dst + (size_t)(n0 + n) * ldd + dcol0 + k0 + 8 * c) = o; }
        asm volatile("s_waitcnt lgkmcnt(0)" ::: "memory");
    }
}
__device__ __forceinline__ void zero_bytes_c(const Frame& F, void* p, size_t nbytes) {
    u32x4* q = (u32x4*)p; const size_t n = nbytes / 16; unsigned z = 0; asm volatile("" : "+v"(z));
    for (size_t i = (size_t)F.cbid * NTHR + F.tid; i < n; i += (size_t)F.cG * NTHR) q[i] = (u32x4){z, z, z, z};
}
__device__ __forceinline__ void zero_bytes(const Frame& F, void* p, size_t nbytes) {
    u32x4* q = (u32x4*)p; const size_t n = nbytes / 16; unsigned z = 0; asm volatile("" : "+v"(z));
    for (size_t i = (size_t)F.bid * NTHR + F.tid; i < n; i += (size_t)F.G * NTHR) q[i] = (u32x4){z, z, z, z};
}

__device__ __forceinline__ void norm_row(const float* xrow, const float* g, const float* sc, const float* sh, int lane, f32x4 (&h)[4]) {
    float s = 0.f;
#pragma unroll
    for (int jx = 0; jx < 4; ++jx) { h[jx] = *(const f32x4*)(xrow + 4 * lane + 256 * jx); s += (h[jx][0] * h[jx][0] + h[jx][1] * h[jx][1]) + (h[jx][2] * h[jx][2] + h[jx][3] * h[jx][3]); }
    const float rinv = rsqrtf(wave_sum(s) * (1.0f / 1024.0f) + 1e-6f);
#pragma unroll
    for (int jx = 0; jx < 4; ++jx) { const f32x4 gg = *(const f32x4*)(g + 4 * lane + 256 * jx), ss = *(const f32x4*)(sc + 4 * lane + 256 * jx), hh = *(const f32x4*)(sh + 4 * lane + 256 * jx);
        h[jx] = h[jx] * rinv * gg * (ss + 1.0f) + hh; }
}

template <int NR>
__device__ __forceinline__ void norm_rows(const float* x0, unsigned vmask, const float* g, const float* sc, const float* sh, int lane, f32x4 (&h)[NR][4]) {
    float s[NR];
#pragma unroll
    for (int r = 0; r < NR; ++r) { s[r] = 0.f;
#pragma unroll
        for (int jx = 0; jx < 4; ++jx) h[r][jx] = ((vmask >> r) & 1u) ? *(const f32x4*)(x0 + (size_t)r * D + 4 * lane + 256 * jx) : (f32x4){0.f, 0.f, 0.f, 0.f}; }
    f32x4 gm[4], hh[4];
#pragma unroll
    for (int jx = 0; jx < 4; ++jx) { const f32x4 gg = *(const f32x4*)(g + 4 * lane + 256 * jx), ss = *(const f32x4*)(sc + 4 * lane + 256 * jx); hh[jx] = *(const f32x4*)(sh + 4 * lane + 256 * jx); gm[jx] = gg * (ss + 1.0f); }
#pragma unroll
    for (int r = 0; r < NR; ++r)
#pragma unroll
        for (int jx = 0; jx < 4; ++jx) s[r] += (h[r][jx][0] * h[r][jx][0] + h[r][jx][1] * h[r][jx][1]) + (h[r][jx][2] * h[r][jx][2] + h[r][jx][3] * h[r][jx][3]);
#pragma unroll
    for (int o = 1; o < 64; o <<= 1) {
#pragma unroll
        for (int r = 0; r < NR; ++r) s[r] += __shfl_xor(s[r], o); }
#pragma unroll
    for (int r = 0; r < NR; ++r) { const float rinv = rsqrtf(s[r] * (1.0f / 1024.0f) + 1e-6f); const bool ok = (vmask >> r) & 1u;
#pragma unroll
        for (int jx = 0; jx < 4; ++jx) h[r][jx] = ok ? h[r][jx] * rinv * gm[jx] + hh[jx] : (f32x4){0.f, 0.f, 0.f, 0.f}; }
}

__device__ __forceinline__ void phase_p0(const Frame& F) {
    LAS float* sl = (LAS float*)F.lds;
    LAS float* red = (LAS float*)(F.lds + 36864);
    const float* c = IN(F, 5); const float* cctx = IN(F, 6);
    for (int i = F.tid; i < NCOND * 1024; i += NTHR) { const int cb = i >> 10, d = i & 1023; const float v = cb == 0 ? cctx[d] : c[(cb - 1) * 1024 + d]; sl[i] = v / (1.0f + __expf(-v)); }
    __syncthreads();
    float* modv = (float*)(F.ws + WS_MODV);
    const int dg = F.tid >> 4, c4 = F.tid & 15;
    for (int it = F.bid; it < 4 * 96; it += F.G) {
        const int l = it / 96, ch = it % 96;
        const float* W = IN(F, 8) + (size_t)l * 1024 * 6144 + ch * 64 + 4 * c4;
        f32x4 acc[NCOND];
#pragma unroll
        for (int cb = 0; cb < NCOND; ++cb) acc[cb] = (f32x4){0.f, 0.f, 0.f, 0.f};
#pragma unroll 4
        for (int dd = 0; dd < 32; ++dd) { const int d = dg * 32 + dd; const f32x4 wv = *(const f32x4*)(W + (size_t)d * 6144);
#pragma unroll
            for (int cb = 0; cb < NCOND; ++cb) acc[cb] += wv * sl[cb * 1024 + d]; }
#pragma unroll
        for (int cb = 0; cb < NCOND; ++cb) *(LAS f32x4*)(red + (dg * NCOND + cb) * 64 + 4 * c4) = acc[cb];
        __syncthreads();
        for (int o = F.tid; o < NCOND * 64; o += NTHR) { const int cb = o >> 6, cc = o & 63; float s = 0.f;
#pragma unroll 8
            for (int gq = 0; gq < 32; ++gq) s += red[(gq * NCOND + cb) * 64 + cc];
            const int col = ch * 64 + cc;
            modv[((size_t)(l * NCOND + cb)) * 6144 + col] = s + IN(F, 9)[l * 6144 + col]; }
        __syncthreads();
    }
}

__device__ __forceinline__ void conv_w2(const Frame& F, int l) { conv_t(F, IN(F, 11) + (size_t)l * FF * D, FF, D, (bf16_t*)(F.ws + WS_WT + WT_W2), FF, 0, nullptr); }
__device__ __forceinline__ void conv_mlp(const Frame& F, int l) {
    conv_t(F, IN(F, 10) + (size_t)l * D * FF, D, FF, (bf16_t*)(F.ws + WS_WT + WT_W1), D, 0, nullptr);
}
__device__ __forceinline__ void conv_rwkv(const Frame& F, int l) {
    const int i = l >> 1;
    bf16_t* cat = (bf16_t*)(F.ws + WS_WT + WT_CAT);
    const float* mu = IN(F, 12) + (size_t)i * 6 * D;
    for (int j = 0; j < 3; ++j) { const float* W = IN(F, 13) + ((size_t)i * 3 + j) * D * D;
        conv_t(F, W, D, D, cat + (size_t)j * 1024 * 2048, 2048, 0, nullptr);
        conv_t(F, W, D, D, cat + (size_t)j * 1024 * 2048, 2048, 1024, mu + j * D); }
    for (int d = 0; d < 2; ++d) {
        const float* W1 = IN(F, 16) + ((size_t)i * 2 + d) * D * 64; const float* A1 = IN(F, 19) + ((size_t)i * 2 + d) * D * 64;
        conv_t(F, W1, D, 64, cat + (size_t)(3072 + 64 * d) * 2048, 2048, 0, nullptr); conv_t(F, W1, D, 64, cat + (size_t)(3072 + 64 * d) * 2048, 2048, 1024, mu + 3 * D);
        conv_t(F, A1, D, 64, cat + (size_t)(3200 + 64 * d) * 2048, 2048, 0, nullptr); conv_t(F, A1, D, 64, cat + (size_t)(3200 + 64 * d) * 2048, 2048, 1024, mu + 4 * D);
        conv_t(F, IN(F, 17) + ((size_t)i * 2 + d) * 64 * D, 64, D, (bf16_t*)(F.ws + WS_WT + WT_W2S) + (size_t)d * 1024 * 64, 64, 0, nullptr);
        conv_t(F, IN(F, 20) + ((size_t)i * 2 + d) * 64 * D, 64, D, (bf16_t*)(F.ws + WS_WT + WT_A2S) + (size_t)d * 1024 * 64, 64, 0, nullptr);
    }
    { const float* G1 = IN(F, 21) + (size_t)i * D * 128;
      conv_t(F, G1, D, 128, cat + (size_t)3328 * 2048, 2048, 0, nullptr); conv_t(F, G1, D, 128, cat + (size_t)3328 * 2048, 2048, 1024, mu + 5 * D); }
    zero_bytes_c(F, cat + (size_t)3456 * 2048, (size_t)128 * 2048 * 2);
    bf16_t* g2t = (bf16_t*)(F.ws + WS_WT + WT_G2);
    conv_t(F, IN(F, 22) + (size_t)i * 128 * D, 128, D, g2t, 128, 0, nullptr);
    conv_t(F, IN(F, 14) + (size_t)i * D * D, D, D, (bf16_t*)(F.ws + WS_WT + WT_WO), D, 0, nullptr);
    conv_mlp(F, l);
}
__device__ __forceinline__ void conv_na(const Frame& F, int l) {
    const int i = l >> 1;
    conv_t(F, IN(F, 28) + (size_t)i * D * 3072, D, 3072, (bf16_t*)(F.ws + WS_WT + WT_QKV), D, 0, nullptr);
    conv_t(F, IN(F, 29) + (size_t)i * D * D, D, D, (bf16_t*)(F.ws + WS_WT + WT_WO), D, 0, nullptr);
    conv_mlp(F, l);
    bf16_t* ckb = (bf16_t*)(F.ws + WS_ACT + A_CKB); bf16_t* cvt = (bf16_t*)(F.ws + WS_ACT + A_CVT);
    for (int e = F.cbid * NTHR + F.tid; e < 8 * 16 * 256 * 64 / 4; e += F.cG * NTHR) {
        const int b = e / (16 * 256 * 16), r = e % (16 * 256 * 16);
        const f32x4 v = *(const f32x4*)(IN(F, 3) + ((size_t)(b * 2 + i) * 16 * 256 * 64) + (size_t)r * 4);
        u32x2 w; w.x = cvt_pk_bf16(v[0], v[1]); w.y = cvt_pk_bf16(v[2], v[3]);
        *(u32x2*)(ckb + (size_t)b * 16 * 256 * 64 + (size_t)r * 4) = w; }
    for (int b = 0; b < 8; ++b)
        conv_t(F, IN(F, 4) + ((size_t)((b * 2 + i) * 16)) * 256 * 64, 256, 64, cvt + (size_t)b * 16 * 64 * 256, 256, 0, nullptr, 16, (size_t)256 * 64, (size_t)64 * 256);
}

__device__ __forceinline__ void phase_norm(const Frame& F, int l, int which) {
    const float* modv = (const float*)(F.ws + WS_MODV) + (size_t)l * NCOND * 6144;
    const float* g = IN(F, 7) + (size_t)(l * 2 + which) * D;
    bf16_t* HN = (bf16_t*)(F.ws + WS_ACT + A_HN);
    const int gw = F.bid * NWAVES + F.wave, NGW = F.G * NWAVES, lane = F.lane;
    for (int row = 2 * gw; row < MTOK; row += 2 * NGW) {
        const float* mv = modv + (size_t)cond_of_row(row) * 6144 + which * 3 * 1024;
        f32x4 h[2][4]; norm_rows<2>(F.out + (size_t)row * D, 3u, g, mv + 1024, mv, lane, h);
#pragma unroll
        for (int r = 0; r < 2; ++r)
#pragma unroll
            for (int jx = 0; jx < 4; ++jx) { u32x2 w; w.x = cvt_pk_bf16(h[r][jx][0], h[r][jx][1]); w.y = cvt_pk_bf16(h[r][jx][2], h[r][jx][3]); *(u32x2*)(HN + (size_t)(row + r) * D + 4 * lane + 256 * jx) = w; }
    }
}
__device__ __forceinline__ void phase_pre_rwkv(const Frame& F, int l) {
    const float* modv = (const float*)(F.ws + WS_MODV) + (size_t)l * NCOND * 6144;
    const float* g = IN(F, 7) + (size_t)(l * 2) * D;
    bf16_t* H2 = (bf16_t*)(F.ws + WS_ACT + A_H2);
    const int gw = F.bid * NWAVES + F.wave, NGW = F.G * NWAVES, lane = F.lane;
    for (int row = 2 * gw; row < MTOK; row += 2 * NGW) {
        const float* mv = modv + (size_t)cond_of_row(row) * 6144;
        int t, T; if (row < MCTX) { t = row & 255; T = 256; } else { t = (row - MCTX) & 4095; T = 4096; }
        const unsigned vmask = (t > 0 ? 1u : 0u) | 6u | (t + 2 < T ? 8u : 0u);
        const float* xsrc = l == 0 ? (row < MCTX ? IN(F, 0) + (size_t)row * D : IN(F, 1) + (size_t)(row - MCTX) * D) : F.out + (size_t)row * D;
        f32x4 h[4][4]; norm_rows<4>(xsrc - D, vmask, g, mv + 1024, mv, lane, h);
#pragma unroll
        for (int r = 0; r < 2; ++r)
#pragma unroll
            for (int jx = 0; jx < 4; ++jx) { const f32x4 hc = h[r + 1][jx], dl = (h[r][jx] + h[r + 2][jx]) * 0.5f - hc;
                u32x2 w; w.x = cvt_pk_bf16(hc[0], hc[1]); w.y = cvt_pk_bf16(hc[2], hc[3]); *(u32x2*)(H2 + (size_t)(row + r) * 2048 + 4 * lane + 256 * jx) = w;
                u32x2 w2; w2.x = cvt_pk_bf16(dl[0], dl[1]); w2.y = cvt_pk_bf16(dl[2], dl[3]); *(u32x2*)(H2 + (size_t)(row + r) * 2048 + 1024 + 4 * lane + 256 * jx) = w2; }
    }
}

constexpr int SC_ST = 388;
constexpr int SC_BUF = 16 * SC_ST * 4;
constexpr int SC_GRP = 2 * SC_BUF + 1024 + 256 + 16384;
__device__ __forceinline__ void phase_scan(const Frame& F, int l, float yscale) {
    const int i = l >> 1, lane = F.lane;
    const int grp = F.wave >> 2, w = F.wave & 3;
    LAS unsigned char* gl = F.lds + grp * SC_GRP;
    LAS float* part = (LAS float*)(gl + 2 * SC_BUF);
    LAS float* rin = (LAS float*)(gl + 2 * SC_BUF + 1024) + w * 16;
    LAS float* ybuf = (LAS float*)(gl + 2 * SC_BUF + 1280) + w * 1024;
    const bf16_t* RK = (const bf16_t*)(F.ws + WS_ACT + A_RKVL);
    float* Y = (float*)(F.ws + WS_ACT + A_H2);
    float* CS = (float*)(F.ws + WS_CS);
    const int nitems = grp == 0 ? 256 : 512, cpi = grp == 0 ? 256 : 16;
    int nmine = 0; for (int it = F.bid; it < nitems; it += F.G) ++nmine;
    int nother = 0; { const int ni2 = grp == 0 ? 512 : 256; for (int it = F.bid; it < ni2; it += F.G) ++nother; }
    const int nb_mine = nmine * (1 + cpi), nb_oth = nother * (1 + (grp == 0 ? 16 : 256));
    const int pn = lane & 15, g4 = lane >> 4, dbase = 16 * w + 4 * g4;
    const int oc = lane & 7, pr = lane >> 3, vrow = 16 * w + 2 * pr;
    int par = 0;
#define SC_BAR() do { asm volatile("s_waitcnt lgkmcnt(0)" ::: "memory"); __builtin_amdgcn_s_barrier(); asm volatile("" ::: "memory"); } while (0)
    for (int item = F.bid; item < nitems; item += F.G) {
        const int b = item >> 5, h = (item >> 1) & 15, dir = item & 1;
        const int base_row = grp == 0 ? MCTX + b * 4096 : b * 256, T = grp == 0 ? 4096 : 256;
        f32x2 S0[4], S1[4];
        if (grp == 0) { const float* sp = IN(F, 2) + ((size_t)(((b * 2 + i) * 2 + dir) * 16 + h)) * 4096 + vrow * 64 + 8 * oc;
#pragma unroll
            for (int e2 = 0; e2 < 2; ++e2) { const f32x4 v0 = *(const f32x4*)(sp + 4 * e2), v1 = *(const f32x4*)(sp + 64 + 4 * e2);
                S0[2 * e2] = (f32x2){v0[0], v0[1]}; S0[2 * e2 + 1] = (f32x2){v0[2], v0[3]}; S1[2 * e2] = (f32x2){v1[0], v1[1]}; S1[2 * e2 + 1] = (f32x2){v1[2], v1[3]}; }
        } else {
#pragma unroll
            for (int e = 0; e < 4; ++e) { S0[e] = (f32x2){0.f, 0.f}; S1[e] = (f32x2){0.f, 0.f}; } }
        const bf16_t* wp = (const bf16_t*)(F.ws + WS_WT + WT_W2S) + ((size_t)dir * 1024 + h * 64 + 16 * w + pn) * 64 + 8 * g4;
        const bf16_t* ap = (const bf16_t*)(F.ws + WS_WT + WT_A2S) + ((size_t)dir * 1024 + h * 64 + 16 * w + pn) * 64 + 8 * g4;
        const bf16x8 ww0 = *(const bf16x8*)wp, ww1 = *(const bf16x8*)(wp + 32), wa0 = *(const bf16x8*)ap, wa1 = *(const bf16x8*)(ap + 32);
        const int dc = h * 64 + dbase;
        const f32x4 w0v = *(const f32x4*)(IN(F, 15) + (size_t)(i * 2 + dir) * D + dc), a0v = *(const f32x4*)(IN(F, 18) + (size_t)(i * 2 + dir) * D + dc);
        const f32x4 kkv = *(const f32x4*)(IN(F, 23) + (size_t)i * D + dc), kav = *(const f32x4*)(IN(F, 24) + (size_t)i * D + dc), rkv = *(const f32x4*)(IN(F, 25) + (size_t)i * D + dc);
        u32x2 ld_k, ld_r, ld_v; bf16x8 lw0, lw1, la0, la1; float ld_ri;
#define SC_PREFETCH(cc) do { const int s0_ = 16 * (cc) + pn; const int t0_ = dir == 0 ? s0_ : T - 1 - s0_; const bf16_t* rp_ = RK + (size_t)(base_row + t0_) * LDR; \
            ld_r = *(const u32x2*)(rp_ + dc); ld_k = *(const u32x2*)(rp_ + 1024 + dc); ld_v = *(const u32x2*)(rp_ + 2048 + dc); ld_ri = ((const float*)(rp_ + 3456))[h]; \
            lw0 = *(const bf16x8*)(rp_ + 3072 + 64 * dir + 8 * g4); lw1 = *(const bf16x8*)(rp_ + 3072 + 64 * dir + 32 + 8 * g4); \
            la0 = *(const bf16x8*)(rp_ + 3200 + 64 * dir + 8 * g4); la1 = *(const bf16x8*)(rp_ + 3200 + 64 * dir + 32 + 8 * g4); } while (0)
        f32x4 P0, P1, P2, P3, P4, P5; float Pssq, Pcp;
        f32x4 q_dec, q_av, q_cin, q_cex, q_rc, q_kf, q_rf, q_vf; float q_ri;
#define SC_PREP_A() do { f32x4 z_ = (f32x4){0.f, 0.f, 0.f, 0.f}, za_ = (f32x4){0.f, 0.f, 0.f, 0.f}; \
            z_ = __builtin_amdgcn_mfma_f32_16x16x32_bf16(ww0, lw0, z_, 0, 0, 0); z_ = __builtin_amdgcn_mfma_f32_16x16x32_bf16(ww1, lw1, z_, 0, 0, 0); \
            za_ = __builtin_amdgcn_mfma_f32_16x16x32_bf16(wa0, la0, za_, 0, 0, 0); za_ = __builtin_amdgcn_mfma_f32_16x16x32_bf16(wa1, la1, za_, 0, 0, 0); \
            q_kf = (f32x4){bf_lo(ld_k.x), bf_hi(ld_k.x), bf_lo(ld_k.y), bf_hi(ld_k.y)}; \
            q_rf = (f32x4){bf_lo(ld_r.x), bf_hi(ld_r.x), bf_lo(ld_r.y), bf_hi(ld_r.y)}; \
            q_vf = (f32x4){bf_lo(ld_v.x), bf_hi(ld_v.x), bf_lo(ld_v.y), bf_hi(ld_v.y)}; q_ri = ld_ri; \
            _Pragma("unroll") for (int jj = 0; jj < 4; ++jj) { q_dec[jj] = __expf(-0.60653066f * sigmoidf_(w0v[jj] + z_[jj])); q_av[jj] = sigmoidf_(a0v[jj] + za_[jj]); } } while (0)
#define SC_PREP_B() do { _Pragma("unroll") for (int jj = 0; jj < 4; ++jj) { float c_ = q_dec[jj]; \
                c_ *= dpp_row_shr_or1<1>(c_); c_ *= dpp_row_shr_or1<2>(c_); c_ *= dpp_row_shr_or1<4>(c_); c_ *= dpp_row_shr_or1<8>(c_); \
                q_cin[jj] = c_; q_cex[jj] = dpp_row_shr_or1<1>(c_); q_rc[jj] = __builtin_amdgcn_rcpf(c_); } } while (0)
#define SC_PREP_C() do { const f32x4 kkp_ = q_kf * kkv, kd_ = q_kf * ((q_av - 1.0f) * kav + 1.0f), bq_ = kkp_ * q_av; \
            const f32x4 rk3_ = q_rf * kd_ * rkv; float cp_ = (rk3_[0] + rk3_[1]) + (rk3_[2] + rk3_[3]); \
            cp_ += __shfl_xor(cp_, 16); cp_ += __shfl_xor(cp_, 32); \
            P0 = q_cin; P1 = kkp_ * q_cex * (-q_ri); P2 = bq_ * q_rc; P3 = kd_ * q_rc; P4 = q_rf * q_cin; P5 = q_vf; Pssq = 0.f; Pcp = cp_; } while (0)
#define SC_PREP() do { SC_PREP_A(); SC_PREP_B(); SC_PREP_C(); } while (0)
#define SC_PREP_STORE(pp) do { LAS float* bp_ = (LAS float*)(gl + (pp) * SC_BUF) + pn * SC_ST + dbase; \
            *(LAS f32x4*)(bp_) = P0; *(LAS f32x4*)(bp_ + 64) = P1; *(LAS f32x4*)(bp_ + 128) = P2; *(LAS f32x4*)(bp_ + 192) = P3; *(LAS f32x4*)(bp_ + 256) = P4; *(LAS f32x4*)(bp_ + 320) = P5; \
            if (g4 == 0) { part[((pp) * 2 + 1) * 64 + pn * 4 + w] = Pcp; } } while (0)
#define SC_FLUSH(cc, hh) do { float* yb_ = Y + (size_t)base_row * D + h * 64 + 16 * w; \
            _Pragma("unroll") for (int k2 = 0; k2 < 2; ++k2) { const int idx = lane + 64 * k2, n_ = idx >> 4, rr = idx & 15; const int sidx = 16 * (cc) + 8 * (hh) + n_; const int t_ = dir == 0 ? sidx : T - 1 - sidx; \
                const int yo_ = n_ * 128 + (rr & 1) * 64 + (rr >> 1) * 8; const f32x4 pa_ = *(const LAS f32x4*)(ybuf + yo_), pb_ = *(const LAS f32x4*)(ybuf + yo_ + 4); \
                atomicAdd(yb_ + (size_t)t_ * D + rr, (((pa_[0] + pa_[1]) + (pa_[2] + pa_[3])) + ((pb_[0] + pb_[1]) + (pb_[2] + pb_[3]))) * yscale); } } while (0)
        par ^= 1;
        SC_PREFETCH(0); SC_PREP(); SC_PREP_STORE(par);
        if (cpi > 1) SC_PREFETCH(1);
        SC_BAR();
        for (int cidx = 0; cidx < cpi; ++cidx) {
            const LAS float* buf = (const LAS float*)(gl + par * SC_BUF);
            if (lane < 16) {
                if (w == 0) { const f32x4 c4 = *(const LAS f32x4*)(part + (par * 2 + 1) * 64 + lane * 4); const int s0 = 16 * cidx + lane; const int t0 = dir == 0 ? s0 : T - 1 - s0;
                    CS[(size_t)(base_row + t0) * 32 + h * 2 + dir] = (c4[0] + c4[1]) + (c4[2] + c4[3]); } }
            asm volatile("s_waitcnt lgkmcnt(0)" ::: "memory");
            const bool more = cidx + 1 < cpi;
            f32x4 L[2][8]; f32x2 vvb[2];
#define SC_LOAD(nn, sl) do { const LAS float* vb_ = buf + (nn) * SC_ST + 8 * oc; _Pragma("unroll") for (int e2 = 0; e2 < 2; ++e2) { \
                L[sl][e2] = *(const LAS f32x4*)(vb_ + 64 + 4 * e2); L[sl][2 + e2] = *(const LAS f32x4*)(vb_ + 128 + 4 * e2); \
                L[sl][4 + e2] = *(const LAS f32x4*)(vb_ + 192 + 4 * e2); L[sl][6 + e2] = *(const LAS f32x4*)(vb_ + 256 + 4 * e2); } \
                vvb[sl] = *(const LAS f32x2*)(buf + (nn) * SC_ST + 320 + vrow); } while (0)
            SC_LOAD(0, 0);
#pragma unroll
            for (int n = 0; n < 16; ++n) {
                const int sl = n & 1;
                if (n < 15) SC_LOAD(n + 1, sl ^ 1);
                f32x2 kk2[4], b2[4], k2[4], r2[4];
#pragma unroll
                for (int e2 = 0; e2 < 2; ++e2) { const f32x4 c = L[sl][e2], d = L[sl][2 + e2], e = L[sl][4 + e2], f = L[sl][6 + e2];
                    kk2[2 * e2] = (f32x2){c[0], c[1]}; kk2[2 * e2 + 1] = (f32x2){c[2], c[3]}; b2[2 * e2] = (f32x2){d[0], d[1]}; b2[2 * e2 + 1] = (f32x2){d[2], d[3]};
                    k2[2 * e2] = (f32x2){e[0], e[1]}; k2[2 * e2 + 1] = (f32x2){e[2], e[3]}; r2[2 * e2] = (f32x2){f[0], f[1]}; r2[2 * e2 + 1] = (f32x2){f[2], f[3]}; }
                const f32x2 vv = vvb[sl];
                f32x2 d0 = S0[0] * kk2[0], d1 = S1[0] * kk2[0];
#pragma unroll
                for (int e = 1; e < 4; ++e) { d0 += S0[e] * kk2[e]; d1 += S1[e] * kk2[e]; }
                const float sa0 = oct_sum(d0.x + d0.y), sa1 = oct_sum(d1.x + d1.y);
                const f32x2 sa0v = (f32x2){sa0, sa0}, sa1v = (f32x2){sa1, sa1}, v0v = (f32x2){vv.x, vv.x}, v1v = (f32x2){vv.y, vv.y};
                f32x2 y0 = (f32x2){0.f, 0.f}, y1 = (f32x2){0.f, 0.f};
#pragma unroll
                for (int e = 0; e < 4; ++e) {
                    S0[e] = S0[e] + sa0v * b2[e] + v0v * k2[e]; S1[e] = S1[e] + sa1v * b2[e] + v1v * k2[e];
                    y0 += S0[e] * r2[e]; y1 += S1[e] * r2[e]; }
                { LAS float* yp_ = ybuf + (n & 7) * 128 + pr * 8 + oc; yp_[0] = y0.x + y0.y; yp_[64] = y1.x + y1.y; }
                if (n == 7) SC_FLUSH(cidx, 0);
                if (n == 15) SC_FLUSH(cidx, 1);
                if (n == 1) SC_PREP_A();
                if (n == 3) { const int c2 = cidx + 2 < cpi ? cidx + 2 : cpi - 1; SC_PREFETCH(c2); }
                if (n == 6) SC_PREP_B();
                if (n == 10) SC_PREP_C();
            }
#undef SC_LOAD
            {
                const f32x4 ca = *(const LAS f32x4*)(buf + 15 * SC_ST + 8 * oc), cb = *(const LAS f32x4*)(buf + 15 * SC_ST + 8 * oc + 4);
                const f32x2 ce[4] = {(f32x2){ca[0], ca[1]}, (f32x2){ca[2], ca[3]}, (f32x2){cb[0], cb[1]}, (f32x2){cb[2], cb[3]}};
#pragma unroll
                for (int e = 0; e < 4; ++e) { S0[e] = S0[e] * ce[e]; S1[e] = S1[e] * ce[e]; }
            }
            par ^= 1;
            if (more) SC_PREP_STORE(par);
            SC_BAR();
        }
        par ^= 1;
        if (grp == 1) { float* op = F.out + O_STATE + ((size_t)(((b * 2 + i) * 2 + dir) * 16 + h)) * 4096 + vrow * 64 + 8 * oc;
#pragma unroll
            for (int e2 = 0; e2 < 2; ++e2) { *(f32x4*)(op + 4 * e2) = (f32x4){S0[2 * e2].x, S0[2 * e2].y, S0[2 * e2 + 1].x, S0[2 * e2 + 1].y};
                *(f32x4*)(op + 64 + 4 * e2) = (f32x4){S1[2 * e2].x, S1[2 * e2].y, S1[2 * e2 + 1].x, S1[2 * e2 + 1].y}; } }
#undef SC_PREFETCH
#undef SC_PREP
#undef SC_PREP_A
#undef SC_PREP_B
#undef SC_PREP_C
#undef SC_PREP_STORE
#undef SC_FLUSH
    }
    for (int k = nb_mine; k < nb_oth; ++k) SC_BAR();
#undef SC_BAR
    __syncthreads();
}

__device__ __forceinline__ void phase_combine(const Frame& F, int l) {
    const int i = l >> 1;
    bf16_t* RK = (bf16_t*)(F.ws + WS_ACT + A_RKVL);
    const float* Y = (const float*)(F.ws + WS_ACT + A_H2);
    const float* CS = (const float*)(F.ws + WS_CS);
    const bf16_t* G = (const bf16_t*)(F.ws + WS_ACT + A_G);
    const int gw = F.bid * NWAVES + F.wave, NGW = F.G * NWAVES, lane = F.lane;
    const int hh = lane >> 2, col = hh * 64 + 16 * (lane & 3);
    f32x4 lw[4], lb[4];
#pragma unroll
    for (int e4 = 0; e4 < 4; ++e4) { lw[e4] = *(const f32x4*)(IN(F, 26) + (size_t)i * D + col + 4 * e4); lb[e4] = *(const f32x4*)(IN(F, 27) + (size_t)i * D + col + 4 * e4); }
    for (int row = gw; row < MTOK; row += NGW) {
        f32x4 y[4]; float s = 0.f;
#pragma unroll
        for (int e4 = 0; e4 < 4; ++e4) { y[e4] = *(const f32x4*)(Y + (size_t)row * D + col + 4 * e4); s += (y[e4][0] + y[e4][1]) + (y[e4][2] + y[e4][3]); }
        const float mean = quad_sum(s) * (1.0f / 64.0f); float q2 = 0.f;
#pragma unroll
        for (int e4 = 0; e4 < 4; ++e4) { y[e4] = y[e4] - mean; q2 += (y[e4][0] * y[e4][0] + y[e4][1] * y[e4][1]) + (y[e4][2] * y[e4][2] + y[e4][3] * y[e4][3]); }
        const float rstd = rsqrtf(quad_sum(q2) * (1.0f / 64.0f) + 64e-5f);
        const float cs = CS[(size_t)row * 32 + hh * 2] + CS[(size_t)row * 32 + hh * 2 + 1];
        const u32x4 va = *(const u32x4*)(RK + (size_t)row * LDR + 2048 + col), vb = *(const u32x4*)(RK + (size_t)row * LDR + 2048 + col + 8);
        const u32x4 ga = *(const u32x4*)(G + (size_t)row * D + col), gb = *(const u32x4*)(G + (size_t)row * D + col + 8);
        const unsigned vv[8] = {va.x, va.y, va.z, va.w, vb.x, vb.y, vb.z, vb.w}; const unsigned gg[8] = {ga.x, ga.y, ga.z, ga.w, gb.x, gb.y, gb.z, gb.w};
        unsigned ow[8];
#pragma unroll
        for (int p = 0; p < 8; ++p) { const int e4 = p >> 1, e = (p & 1) * 2;
            const float o0 = (y[e4][e] * rstd * lw[e4][e] + lb[e4][e] + cs * bf_lo(vv[p])) * bf_lo(gg[p]);
            const float o1 = (y[e4][e + 1] * rstd * lw[e4][e + 1] + lb[e4][e + 1] + cs * bf_hi(vv[p])) * bf_hi(gg[p]);
            ow[p] = cvt_pk_bf16(o0, o1); }
        *(u32x4*)(RK + (size_t)row * LDR + col) = (u32x4){ow[0], ow[1], ow[2], ow[3]}; *(u32x4*)(RK + (size_t)row * LDR + col + 8) = (u32x4){ow[4], ow[5], ow[6], ow[7]};
    }
}

template <bool LAT>
__device__ __forceinline__ void attn_task(const Frame& F, int id, int li, LAS unsigned char* lctx) {
    const bf16_t* QK = (const bf16_t*)(F.ws + WS_ACT + A_QK);
    const bf16_t* VT = (const bf16_t*)(F.ws + WS_ACT + A_VT);
    const bf16_t* CKB = (const bf16_t*)(F.ws + WS_ACT + A_CKB);
    const bf16_t* CVT = (const bf16_t*)(F.ws + WS_ACT + A_CVT);
    bf16_t* O = (bf16_t*)(F.ws + WS_ACT + A_HN);
    const int lane = F.lane, n = lane & 15, g = lane >> 4;
    int b, h, qrow0, seq0, r = 0, cb = 0, rs = 0, band = 0;
    if (LAT) { cb = id & 3; r = (id >> 2) & 63; h = (id >> 8) & 15; b = id >> 12; seq0 = MCTX + b * 4096; qrow0 = seq0 + r * 64 + cb * 16;
        rs = r - 4; rs = rs < 0 ? 0 : (rs > 56 ? 56 : rs); band = cb == 0 ? 0 : (cb == 1 ? 8 : (cb == 2 ? 24 : 32)); }
    else { const int qb = id & 15; h = (id >> 4) & 15; b = id >> 8; seq0 = b * 256; qrow0 = seq0 + qb * 16; }
    const bf16_t* Qp = QK + (size_t)(qrow0 + n) * 2048 + h * 64 + 8 * g;
    const bf16x8 q0 = *(const bf16x8*)Qp, q1 = *(const bf16x8*)(Qp + 32);
    const float* rpb = IN(F, 32) + ((size_t)(li * 16 + h)) * 15 * 31;
    const int qcol = cb * 16 + n; int wst = qcol - 8; wst = wst < 0 ? 0 : (wst > 48 ? 48 : wst);
    float m_run = 0.f, l_run = 0.f;
    f32x4 o[4];
#pragma unroll
    for (int dt = 0; dt < 4; ++dt) o[dt] = (f32x4){0.f, 0.f, 0.f, 0.f};
    constexpr int NSEG = LAT ? 2 : 1;
#pragma unroll
    for (int seg = 0; seg < NSEG; ++seg) {
        const bool win = LAT && seg == 0;
        const char* kub; unsigned kvo; size_t kst;
        const int nk = 8 * (n >> 2) + (n & 3);
        if (win) { kub = (const char*)(QK + (size_t)(seq0 + rs * 64 + band) * 2048 + 1024 + h * 64); kvo = (unsigned)(nk * 2048 + 8 * g) * 2u; kst = 0; }
        else if (LAT) { kub = (const char*)(CKB + (size_t)(b * 16 + h) * 256 * 64); kvo = (unsigned)(nk * 64 + 8 * g) * 2u; kst = 64 * 2; }
        else { kub = (const char*)(QK + (size_t)seq0 * 2048 + 1024 + h * 64); kvo = (unsigned)(nk * 2048 + 8 * g) * 2u; kst = (size_t)2048 * 2; }
        f32x4 s[16];
        bf16x8 kb[2][2];
#define AT_LOADK(gi, sl) do { _Pragma("unroll") for (int t = 0; t < 1; ++t) { const int ti = (gi) + t; \
            const char* kp = (win ? kub + ((size_t)(ti >> 1) * 64 + 4 * (ti & 1)) * 4096 : kub + (size_t)(32 * (ti >> 1) + 4 * (ti & 1)) * kst) + kvo; \
            kb[sl][2 * t] = *(const bf16x8*)kp; kb[sl][2 * t + 1] = *(const bf16x8*)(kp + 64); } } while (0)
        const bool cl = LAT && seg == 1;
        const LAS unsigned char* klds = lctx + (unsigned)(nk * 144 + 16 * g);
#define AT_LOADK_L(gi, sl) do { const int ti = (gi); const LAS unsigned char* kp = klds + (32 * (ti >> 1) + 4 * (ti & 1)) * 144; \
            kb[sl][0] = *(const LAS bf16x8*)kp; kb[sl][1] = *(const LAS bf16x8*)(kp + 64); } while (0)
        if (cl) AT_LOADK_L(0, 0); else AT_LOADK(0, 0);
        float mx = -3.0e38f;
#pragma unroll
        for (int gi = 0; gi < 16; ++gi) {
            if (gi < 15) { if (cl) AT_LOADK_L(gi + 1, (gi + 1) & 1); else AT_LOADK(gi + 1, (gi + 1) & 1); }
            __builtin_amdgcn_sched_barrier(0);
#pragma unroll
            for (int t = 0; t < 1; ++t) { const int ti = gi + t;
                f32x4 a = (f32x4){0.f, 0.f, 0.f, 0.f};
                a = __builtin_amdgcn_mfma_f32_16x16x32_bf16(kb[gi & 1][2 * t], q0, a, 0, 0, 0); a = __builtin_amdgcn_mfma_f32_16x16x32_bf16(kb[gi & 1][2 * t + 1], q1, a, 0, 0, 0);
                if (win) { const int j = ti >> 1, half = ti & 1; const float* rp = rpb + (rs + j - r + 7) * 31;
#pragma unroll
                    for (int jj = 0; jj < 4; ++jj) { const int kc = band + 8 * g + 4 * half + jj; const bool valid = kc >= wst && kc < wst + 16;
                        int co = kc - qcol + 15; co = co < 0 ? 0 : (co > 30 ? 30 : co);
                        a[jj] = valid ? a[jj] * 0.125f + rp[co] : -1e30f; }
                } else a = a * 0.125f;
                mx = fmaxf(mx, fmaxf(fmaxf(a[0], a[1]), fmaxf(a[2], a[3])));
                s[ti] = a; }
            __builtin_amdgcn_sched_barrier(0);
        }
#undef AT_LOADK
#undef AT_LOADK_L
        mx = fmaxf(mx, __shfl_xor(mx, 16)); mx = fmaxf(mx, __shfl_xor(mx, 32));
        if (seg > 0) { const float mn = fmaxf(m_run, mx), ea = __expf(m_run - mn); l_run *= ea; mx = mn;
#pragma unroll
            for (int dt = 0; dt < 4; ++dt) o[dt] = o[dt] * ea; }
        m_run = mx;
        float sum = 0.f;
#pragma unroll
        for (int ti = 0; ti < 16; ++ti) {
#pragma unroll
            for (int jj = 0; jj < 4; ++jj) { const float p = __expf(s[ti][jj] - mx); s[ti][jj] = p; sum += p; } }
        sum += __shfl_xor(sum, 16); sum += __shfl_xor(sum, 32);
        l_run += sum;
        const char* vub; unsigned vvo; size_t vsd, vsk;
        if (win) { vub = (const char*)(VT + (size_t)(h * 64) * MTOK + seq0 + rs * 64 + band); vvo = (unsigned)(n * MTOK + 8 * g) * 2u; vsd = (size_t)16 * MTOK * 2; vsk = 64 * 2; }
        else if (LAT) { vub = (const char*)(CVT + (size_t)(b * 16 + h) * 64 * 256); vvo = (unsigned)(n * 256 + 8 * g) * 2u; vsd = 16 * 256 * 2; vsk = 32 * 2; }
        else { vub = (const char*)(VT + (size_t)(h * 64) * MTOK + seq0); vvo = (unsigned)(n * MTOK + 8 * g) * 2u; vsd = (size_t)16 * MTOK * 2; vsk = 32 * 2; }
        bf16x8 vb[2][4];
#define AT_LOADV(ks_, sl) do { _Pragma("unroll") for (int dt = 0; dt < 4; ++dt) { \
            const char* vp = vub + (size_t)dt * vsd + (size_t)(ks_) * vsk + vvo; vb[sl][dt] = *(const bf16x8*)vp; } } while (0)
        const LAS unsigned char* vlds = lctx + 36864 + (unsigned)(n * 528 + 16 * g);
#define AT_LOADV_L(ks_, sl) do { _Pragma("unroll") for (int dt = 0; dt < 4; ++dt) vb[sl][dt] = *(const LAS bf16x8*)(vlds + dt * (16 * 528) + (ks_) * 64); } while (0)
        if (cl) AT_LOADV_L(0, 0); else AT_LOADV(0, 0);
#pragma unroll
        for (int ks = 0; ks < 8; ++ks) {
            if (ks < 7) { if (cl) AT_LOADV_L(ks + 1, (ks + 1) & 1); else AT_LOADV(ks + 1, (ks + 1) & 1); }
            __builtin_amdgcn_sched_barrier(0);
            { const unsigned p0 = cvt_pk_bf16(s[2 * ks][0], s[2 * ks][1]), p1 = cvt_pk_bf16(s[2 * ks][2], s[2 * ks][3]), p2 = cvt_pk_bf16(s[2 * ks + 1][0], s[2 * ks + 1][1]), p3 = cvt_pk_bf16(s[2 * ks + 1][2], s[2 * ks + 1][3]);
                const bf16x8 pf = __builtin_bit_cast(bf16x8, (u32x4){p0, p1, p2, p3});
#pragma unroll
                for (int dt = 0; dt < 4; ++dt) { const bf16x8 vf = vb[ks & 1][dt];
                    o[dt] = __builtin_amdgcn_mfma_f32_16x16x32_bf16(vf, pf, o[dt], 0, 0, 0); } }
            __builtin_amdgcn_sched_barrier(0);
        }
#undef AT_LOADV
#undef AT_LOADV_L
    }
    const float inv = 1.0f / l_run;
    bf16_t* op = O + (size_t)(qrow0 + n) * D + h * 64 + 4 * g;
#pragma unroll
    for (int dt = 0; dt < 4; ++dt) { const f32x4 v = o[dt] * inv; u32x2 w; w.x = cvt_pk_bf16(v[0], v[1]); w.y = cvt_pk_bf16(v[2], v[3]); *(u32x2*)(op + 16 * dt) = w; }
}
constexpr int AL_CK = 0, AL_CV = 36864, AL_WIN = 70656, AL_VST = 1168;
__device__ __forceinline__ int al_swz(int key) { return ((key >> 1) & 1) | (((key >> 3) & 3) << 1); }
__device__ __forceinline__ void attn_lat_block(const Frame& F, int bh, int half, int li) {
    const bf16_t* QK = (const bf16_t*)(F.ws + WS_ACT + A_QK);
    const bf16_t* VT = (const bf16_t*)(F.ws + WS_ACT + A_VT);
    const bf16_t* CKB = (const bf16_t*)(F.ws + WS_ACT + A_CKB);
    const bf16_t* CVT = (const bf16_t*)(F.ws + WS_ACT + A_CVT);
    bf16_t* O = (bf16_t*)(F.ws + WS_ACT + A_HN);
    const int lane = F.lane, n = lane & 15, g = lane >> 4, tid = F.wave * 64 + lane;
    const int b = bh >> 4, h = bh & 15, seq0 = MCTX + b * 4096;
    LAS unsigned char* L = F.lds;
    __syncthreads();
    for (int c = tid; c < 2048; c += NTHR) { const int key = c >> 3, ch = c & 7; *(LAS u32x4*)(L + AL_CK + key * 144 + ch * 16) = *(const u32x4*)(CKB + ((size_t)bh * 256 + key) * 64 + ch * 8); }
    for (int c = tid; c < 2048; c += NTHR) { const int d = c >> 5, ch = c & 31; *(LAS u32x4*)(L + AL_CV + d * 528 + ch * 16) = *(const u32x4*)(CVT + ((size_t)bh * 64 + d) * 256 + ch * 8); }
    const float* rpb = IN(F, 32) + ((size_t)(li * 16 + h)) * 15 * 31;
    const int cb = F.wave & 3, band = cb == 0 ? 0 : (cb == 1 ? 8 : (cb == 2 ? 24 : 32));
    const int qcol = cb * 16 + n; int wst = qcol - 8; wst = wst < 0 ? 0 : (wst > 48 ? 48 : wst);
    const int nk = 8 * (n >> 2) + (n & 3);
    for (int jp = 0; jp < 16; ++jp) {
        const int rA = 32 * half + 2 * jp; int rsA = rA - 4; rsA = rsA < 0 ? 0 : (rsA > 56 ? 56 : rsA);
        const int nrows = (64 - rsA) < 9 ? (64 - rsA) : 9;
        const int r = rA + (F.wave >> 2); int rs = r - 4; rs = rs < 0 ? 0 : (rs > 56 ? 56 : rs);
        const int jl0 = rs - rsA;
        __syncthreads();
        { u32x4 tk[9]; const int key = (tid >> 3) & 63, ch = tid & 7;
#pragma unroll
            for (int j = 0; j < 9; ++j) if (j < nrows) tk[j] = *(const u32x4*)(QK + (size_t)(seq0 + (rsA + j) * 64 + key) * 2048 + 1024 + h * 64 + ch * 8);
#pragma unroll
            for (int j = 0; j < 9; ++j) if (j < nrows) *(LAS u32x4*)(L + AL_WIN + (j * 64 + key) * 128 + ((ch ^ al_swz(key)) * 16)) = tk[j]; }
        const bf16_t* Qp = QK + (size_t)(seq0 + r * 64 + cb * 16 + n) * 2048 + h * 64 + 8 * g;
        const bf16x8 q0 = *(const bf16x8*)Qp, q1 = *(const bf16x8*)(Qp + 32);
        __syncthreads();
        f32x4 s[32];
        float mx = -3.0e38f;
#pragma unroll
        for (int ti = 0; ti < 16; ++ti) { const int j = ti >> 1, hf = ti & 1;
            const int kc = band + nk + 4 * hf, sw = al_swz(kc);
            const LAS unsigned char* kp = L + AL_WIN + ((jl0 + j) * 64 + kc) * 128;
            const bf16x8 k0 = *(const LAS bf16x8*)(kp + ((g ^ sw) * 16)), k1 = *(const LAS bf16x8*)(kp + (((4 + g) ^ sw) * 16));
            f32x4 a = (f32x4){0.f, 0.f, 0.f, 0.f};
            a = __builtin_amdgcn_mfma_f32_16x16x32_bf16(k0, q0, a, 0, 0, 0); a = __builtin_amdgcn_mfma_f32_16x16x32_bf16(k1, q1, a, 0, 0, 0);
            const float* rp = rpb + (rs + j - r + 7) * 31;
#pragma unroll
            for (int jj = 0; jj < 4; ++jj) { const int kcc = band + 8 * g + 4 * hf + jj; const bool valid = kcc >= wst && kcc < wst + 16;
                int co = kcc - qcol + 15; co = co < 0 ? 0 : (co > 30 ? 30 : co);
                a[jj] = valid ? a[jj] * 0.125f + rp[co] : -1e30f; }
            mx = fmaxf(mx, fmaxf(fmaxf(a[0], a[1]), fmaxf(a[2], a[3])));
            s[ti] = a; }
#pragma unroll
        for (int ti = 0; ti < 16; ++ti) { const int key = 32 * (ti >> 1) + 4 * (ti & 1) + nk;
            const LAS unsigned char* kp = L + AL_CK + key * 144 + 16 * g;
            const bf16x8 k0 = *(const LAS bf16x8*)kp, k1 = *(const LAS bf16x8*)(kp + 64);
            f32x4 a = (f32x4){0.f, 0.f, 0.f, 0.f};
            a = __builtin_amdgcn_mfma_f32_16x16x32_bf16(k0, q0, a, 0, 0, 0); a = __builtin_amdgcn_mfma_f32_16x16x32_bf16(k1, q1, a, 0, 0, 0);
            a = a * 0.125f; mx = fmaxf(mx, fmaxf(fmaxf(a[0], a[1]), fmaxf(a[2], a[3])));
            s[16 + ti] = a; }
        mx = fmaxf(mx, __shfl_xor(mx, 16)); mx = fmaxf(mx, __shfl_xor(mx, 32));
        float sum = 0.f;
#pragma unroll
        for (int ti = 0; ti < 32; ++ti) {
#pragma unroll
            for (int jj = 0; jj < 4; ++jj) { const float p = __expf(s[ti][jj] - mx); s[ti][jj] = p; sum += p; } }
        sum += __shfl_xor(sum, 16); sum += __shfl_xor(sum, 32);
        __syncthreads();
        { const int d = tid >> 3, ch = tid & 7;
#pragma unroll
          for (int hb = 0; hb < 2; ++hb) { u32x4 tv[5];
#pragma unroll
            for (int jq = 0; jq < 5; ++jq) { const int j = 5 * hb + jq; if (j < nrows) tv[jq] = *(const u32x4*)(VT + (size_t)(h * 64 + d) * MTOK + seq0 + (rsA + j) * 64 + ch * 8); }
#pragma unroll
            for (int jq = 0; jq < 5; ++jq) { const int j = 5 * hb + jq; if (j < nrows) *(LAS u32x4*)(L + AL_WIN + d * AL_VST + (j * 64 + ch * 8) * 2) = tv[jq]; } } }
        __syncthreads();
        f32x4 o[4];
#pragma unroll
        for (int dt = 0; dt < 4; ++dt) o[dt] = (f32x4){0.f, 0.f, 0.f, 0.f};
#pragma unroll
        for (int ks = 0; ks < 16; ++ks) {
            const unsigned p0 = cvt_pk_bf16(s[2 * ks][0], s[2 * ks][1]), p1 = cvt_pk_bf16(s[2 * ks][2], s[2 * ks][3]), p2 = cvt_pk_bf16(s[2 * ks + 1][0], s[2 * ks + 1][1]), p3 = cvt_pk_bf16(s[2 * ks + 1][2], s[2 * ks + 1][3]);
            const bf16x8 pf = __builtin_bit_cast(bf16x8, (u32x4){p0, p1, p2, p3});
#pragma unroll
            for (int dt = 0; dt < 4; ++dt) {
                const LAS unsigned char* vp = ks < 8 ? L + AL_WIN + (16 * dt + n) * AL_VST + ((jl0 + ks) * 64 + band + 8 * g) * 2 : L + AL_CV + (16 * dt + n) * 528 + (32 * (ks - 8) + 8 * g) * 2;
                const bf16x8 vf = *(const LAS bf16x8*)vp;
                o[dt] = __builtin_amdgcn_mfma_f32_16x16x32_bf16(vf, pf, o[dt], 0, 0, 0); } }
        const float inv = 1.0f / sum;
        bf16_t* op = O + (size_t)(seq0 + r * 64 + cb * 16 + n) * D + h * 64 + 4 * g;
#pragma unroll
        for (int dt = 0; dt < 4; ++dt) { const f32x4 v = o[dt] * inv; u32x2 w; w.x = cvt_pk_bf16(v[0], v[1]); w.y = cvt_pk_bf16(v[2], v[3]); *(u32x2*)(op + 16 * dt) = w; }
    }
}
__device__ __forceinline__ void phase_attn(const Frame& F, int l) {
    const int li = l >> 1; const int gw = F.bid * NWAVES + F.wave, NGW = F.G * NWAVES;
    for (int bt = F.bid; bt < 256; bt += F.G) attn_lat_block(F, bt >> 1, bt & 1, li);
    __syncthreads();
    for (int id = gw; id < 4096; id += NGW) attn_task<false>(F, id, li, F.lds);
}

#define XB_TMO      128
#define XB_XCNT(j)  (256  + 64 * (j))
#define XB_XSUB(j)  (1280 + 64 * (j))
#define XB_XGEN(j)  (2304 + 64 * (j))
#define XB_TOP      3328
#define XB_TOPGEN   3392
#define XCD_BAR_WORDS 3456
#define XB_SPIN_CAP (1u << 18)
constexpr size_t WS_BAR = 983040;
constexpr int BARST_OFF = 146944 + 384;
__device__ __forceinline__ unsigned xb_ld(unsigned* p)              { return __hip_atomic_load(p, __ATOMIC_RELAXED, __HIP_MEMORY_SCOPE_AGENT); }
__device__ __forceinline__ unsigned xb_add(unsigned* p, unsigned v) { return __hip_atomic_fetch_add(p, v, __ATOMIC_RELAXED, __HIP_MEMORY_SCOPE_AGENT); }
__device__ __forceinline__ unsigned xb_xcc_id() { return (unsigned)__builtin_amdgcn_s_getreg((3 << 11) | 20) & 0xFu; }
#define XB_SPIN(cond, bar) do { unsigned _sp = 0; while (cond) { __builtin_amdgcn_s_sleep(1); \
    if ((++_sp & 255u) == 0u) { if (xb_ld(&(bar)[XB_TMO])) break; if (_sp > XB_SPIN_CAP) { atomicAdd(&(bar)[XB_TMO], 1u); break; } } } } while (0)
__device__ __forceinline__ void xcd_barrier_complete(unsigned* bar, unsigned x, unsigned& nloc, unsigned& nx) {
    const unsigned G = gridDim.x * gridDim.y * gridDim.z;
    unsigned sum, cnt, mine, sp = 0u;
    for (;;) {
        sum = 0u; cnt = 0u; mine = 0u;
#pragma unroll
        for (unsigned j = 0; j < 16; ++j) { const unsigned c = xb_ld(&bar[XB_XCNT(j)]); sum += c; cnt += (c > 0u) ? 1u : 0u; mine = (j == x) ? c : mine; }
        if (sum == G) break;
        __builtin_amdgcn_s_sleep(1);
        if ((++sp & 255u) == 0u) { if (xb_ld(&bar[XB_TMO])) break; if (sp > XB_SPIN_CAP) { atomicAdd(&bar[XB_TMO], 1u); break; } }
    }
    nloc = mine > 0u ? mine : 1u; nx = cnt > 0u ? cnt : 1u;
}
__device__ __forceinline__ void xcd_barrier(unsigned* bar, unsigned x, volatile LAS unsigned* st) {
    asm volatile("s_waitcnt vmcnt(0)" ::: "memory");
    __syncthreads();
    if (threadIdx.x == 0) {
        __builtin_amdgcn_s_waitcnt(0);
        unsigned nloc = st[0], nx = st[1];
        if (nloc == 0u) { xcd_barrier_complete(bar, x, nloc, nx); st[0] = nloc; st[1] = nx; }
        const unsigned old = xb_add(&bar[XB_XSUB(x)], 1u);
        const unsigned gen = old / nloc;
        if (old + 1u == (gen + 1u) * nloc) {
            __builtin_amdgcn_fence(__ATOMIC_RELEASE, "agent");
            asm volatile("s_waitcnt vmcnt(0)" ::: "memory");
            const unsigned og = xb_add(&bar[XB_TOP], 1u);
            const unsigned tg = og / nx;
            if (og + 1u == (tg + 1u) * nx) xb_add(&bar[XB_TOPGEN], 1u);
            else XB_SPIN(xb_ld(&bar[XB_TOPGEN]) == tg, bar);
            __builtin_amdgcn_fence(__ATOMIC_ACQUIRE, "agent");
            xb_add(&bar[XB_XGEN(x)], 1u);
            asm volatile("s_waitcnt vmcnt(0)" ::: "memory");
        } else {
            XB_SPIN(xb_ld(&bar[XB_XGEN(x)]) == gen, bar);
            __builtin_amdgcn_fence(__ATOMIC_ACQUIRE, "agent");
            asm volatile("s_waitcnt vmcnt(0)" ::: "memory");
        }
    }
    __syncthreads();
}

#define LAUNDER_PTR(T, p) { unsigned long long ip_ = (unsigned long long)(p); unsigned lo_ = (unsigned)ip_, hi_ = (unsigned)(ip_ >> 32); asm volatile("" : "+v"(lo_), "+v"(hi_)); \
            lo_ = __builtin_amdgcn_readfirstlane(lo_); hi_ = __builtin_amdgcn_readfirstlane(hi_); p = (T)(__attribute__((address_space(1))) unsigned char*)(((unsigned long long)hi_ << 32) | lo_); }
#define MK_FRAME(F) Frame F; { int wv_ = wave_s; asm volatile("" : "+s"(wv_)); \
          int ln_; asm volatile("v_mbcnt_lo_u32_b32 %0, -1, 0\n\tv_mbcnt_hi_u32_b32 %0, -1, %0" : "=v"(ln_)); \
          int tid = wv_ * 64 + ln_, G = gridDim.x, bid = blockIdx.x; float* outp = args.out; unsigned char* wsp = args.ws; unsigned ldsb = 0; \
          asm volatile("" : "+v"(G), "+v"(bid), "+v"(ldsb)); \
          G = __builtin_amdgcn_readfirstlane(G); bid = __builtin_amdgcn_readfirstlane(bid); ldsb = __builtin_amdgcn_readfirstlane(ldsb); \
          LAUNDER_PTR(float*, outp) LAUNDER_PTR(unsigned char*, wsp) \
          F.lds = (LAS unsigned char*)lds_raw + ldsb; \
          F.tid = tid; F.lane = ln_; F.wave = wv_; F.G = G; F.bid = bid; F.cbid = bid; F.cG = G; F.rot = 0; F.out = outp; F.ws = wsp; }
constexpr int NPHASES = 37;
__global__ void __launch_bounds__(NTHR) mk_fwd(Args args) {
    extern __shared__ __attribute__((aligned(16))) unsigned char lds_raw[];
    cg::grid_group grid = cg::this_grid();
    if (threadIdx.x == 0) { LAS unsigned long long* tab = (LAS unsigned long long*)((LAS unsigned char*)lds_raw + TAB_OFF);
#pragma unroll
        for (int k = 0; k < 33; ++k) tab[k] = (unsigned long long)args.in[k];
        volatile LAS unsigned* st0 = (volatile LAS unsigned*)((LAS unsigned char*)lds_raw + BARST_OFF); st0[0] = 0u; st0[1] = 0u;
        (void)xb_add((unsigned*)(args.ws + WS_BAR) + XB_XCNT(xb_xcc_id()), 1u); }
    const unsigned my_xcc = xb_xcc_id();
    int nsync = 0;
    __syncthreads();
    bool need_sync = false;
    const int wave_s = __builtin_amdgcn_readfirstlane(threadIdx.x >> 6);
    for (int ph = args.lo; ph < args.hi; ++ph) {
        const int l = (ph - 1) / 9, slot = (ph - 1) % 9; const bool rw = (l & 1) == 0;
        if (ph > 0 && !rw && (slot == 3 || slot == 4)) continue;
        if (need_sync) { for (int rep = 0; rep < REP_SYNC; ++rep) { if (nsync == 0) grid.sync(); else xcd_barrier((unsigned*)(args.ws + WS_BAR), my_xcc, (volatile LAS unsigned*)((LAS unsigned char*)lds_raw + BARST_OFF)); ++nsync; } }
        need_sync = true;
        if (ph == 0) { MK_FRAME(F) for (int rep = 0; rep < REP_ELT; ++rep) { phase_p0(F); __syncthreads(); conv_rwkv(F, 0); } continue; }
        switch (slot) {
        case 0: { MK_FRAME(F) float* modv = (float*)(F.ws + WS_MODV) + (size_t)l * NCOND * 6144; pg8::StaticOrder S; (void)modv; (void)S;
                for (int rep = 0; rep < REP_ELT; ++rep) { conv_w2(F, l); if (rw) phase_pre_rwkv(F, l); else phase_norm(F, l, 0); } } break;
        case 1: { MK_FRAME(F) float* modv = (float*)(F.ws + WS_MODV) + (size_t)l * NCOND * 6144; pg8::StaticOrder S; (void)modv; (void)S;
                for (int rep = 0; rep < REP_GEMM; ++rep) {
                if (rw) { pg8::Gemm g{(const bf16_t*)(F.ws + WS_ACT + A_H2), 2048, (const bf16_t*)(F.ws + WS_WT + WT_CAT), 3584, 2048}; S.init(MTOK, 3584, F.G, F.bid, 2);
                          pg8::EpiRKVL E{(bf16_t*)(F.ws + WS_ACT + A_RKVL), IN(F, 23) + (size_t)(l >> 1) * D}; pg8::gemm_phase(F.lds, F.tid, g, S, E); }
                else { pg8::Gemm g{(const bf16_t*)(F.ws + WS_ACT + A_HN), D, (const bf16_t*)(F.ws + WS_WT + WT_QKV), 3072, D}; S.init(MTOK, 3072, F.G, F.bid);
                       pg8::EpiQKV E{(bf16_t*)(F.ws + WS_ACT + A_QK), (bf16_t*)(F.ws + WS_ACT + A_VT), IN(F, 30) + (l >> 1) * 64, IN(F, 31) + (l >> 1) * 64, F.out + O_CK, F.out + O_CV, l >> 1};
                       pg8::gemm_phase(F.lds, F.tid, g, S, E); } }
                } break;
        case 2: { MK_FRAME(F) float* modv = (float*)(F.ws + WS_MODV) + (size_t)l * NCOND * 6144; pg8::StaticOrder S; (void)modv; (void)S;
                if (rw) { for (int rep = 0; rep < REP_GEMM; ++rep) { int k256 = 128; asm volatile("" : "+s"(k256));
                          pg8::Gemm g{(const bf16_t*)(F.ws + WS_ACT + A_RKVL) + 3328, LDR, (const bf16_t*)(F.ws + WS_WT + WT_G2), 1024, k256}; S.init(MTOK, 1024, F.G, F.bid);
                          pg8::EpiBf16<0> E{(bf16_t*)(F.ws + WS_ACT + A_G), D}; pg8::gemm_phase(F.lds, F.tid, g, S, E); }
                          { const int extra = 576 % F.G; if (extra == 0 || F.bid >= extra) { if (extra != 0) { F.cbid = F.bid - extra; F.cG = F.G - extra; }
                              for (int rep = 0; rep < REP_ELT; ++rep) zero_bytes_c(F, F.ws + WS_ACT + A_H2, (size_t)MTOK * D * 4); } } }
                else { for (int rep = 0; rep < REP_ATTN; ++rep) phase_attn(F, l); }
                } break;
        case 3: { MK_FRAME(F) float* modv = (float*)(F.ws + WS_MODV) + (size_t)l * NCOND * 6144; pg8::StaticOrder S; (void)modv; (void)S;
                for (int rep = 0; rep < REP_SCAN; ++rep) phase_scan(F, l, rep == REP_SCAN - 1 ? 1.0f : 0.0f); } break;
        case 4: { MK_FRAME(F) float* modv = (float*)(F.ws + WS_MODV) + (size_t)l * NCOND * 6144; pg8::StaticOrder S; (void)modv; (void)S;
                for (int rep = 0; rep < REP_ELT; ++rep) phase_combine(F, l); } break;
        case 5: { MK_FRAME(F) float* modv = (float*)(F.ws + WS_MODV) + (size_t)l * NCOND * 6144; pg8::StaticOrder S; (void)modv; (void)S;
                for (int rep = 0; rep < REP_GEMM; ++rep) { pg8::Gemm g{(const bf16_t*)(F.ws + WS_ACT + (rw ? A_RKVL : A_HN)), rw ? LDR : D, (const bf16_t*)(F.ws + WS_WT + WT_WO), 1024, D}; S.init(MTOK, 1024, F.G, F.bid);
                  if (l == 0) { pg8::EpiRes<true> E{F.out, modv + 2 * 1024, rep == REP_GEMM - 1 ? 1.0f : 0.0f, F.lds + TAB_OFF}; pg8::gemm_phase(F.lds, F.tid, g, S, E); }
                  else { pg8::EpiRes<false> E{F.out, modv + 2 * 1024, rep == REP_GEMM - 1 ? 1.0f : 0.0f, F.lds + TAB_OFF}; pg8::gemm_phase(F.lds, F.tid, g, S, E); } } } break;
        case 6: { MK_FRAME(F) float* modv = (float*)(F.ws + WS_MODV) + (size_t)l * NCOND * 6144; pg8::StaticOrder S; (void)modv; (void)S;
                for (int rep = 0; rep < REP_ELT; ++rep) phase_norm(F, l, 1); } break;
        case 7: { MK_FRAME(F) float* modv = (float*)(F.ws + WS_MODV) + (size_t)l * NCOND * 6144; pg8::StaticOrder S; (void)modv; (void)S;
                for (int rep = 0; rep < REP_GEMM; ++rep) { pg8::Gemm g{(const bf16_t*)(F.ws + WS_ACT + A_HN), D, (const bf16_t*)(F.ws + WS_WT + WT_W1), FF, D}; S.init(MTOK, FF, F.G, F.bid);
                  pg8::EpiBf16<1> E{(bf16_t*)(F.ws + WS_ACT + A_U), FF}; pg8::gemm_phase(F.lds, F.tid, g, S, E); } } break;
        case 8: { MK_FRAME(F) float* modv = (float*)(F.ws + WS_MODV) + (size_t)l * NCOND * 6144; pg8::StaticOrder S; (void)modv; (void)S;
                for (int rep = 0; rep < REP_GEMM; ++rep) { pg8::Gemm g{(const bf16_t*)(F.ws + WS_ACT + A_U), FF, (const bf16_t*)(F.ws + WS_WT + WT_W2), 1024, FF}; S.init(MTOK, 1024, F.G, F.bid, 2);
                  pg8::EpiRes<false> E{F.out, modv + 5 * 1024, rep == REP_GEMM - 1 ? 1.0f : 0.0f, F.lds + TAB_OFF}; pg8::gemm_phase(F.lds, F.tid, g, S, E); }
                if (l < 3) {
                    const int extra = 576 % F.G; bool doit = true;
                    if (extra != 0) { if (F.bid < extra) doit = false; else { F.cbid = F.bid - extra; F.cG = F.G - extra; } }
                    if (doit) { if (((l + 1) & 1) == 0) conv_rwkv(F, l + 1); else conv_na(F, l + 1); } } } break;
        }
    }
}

extern "C" void kernel_launch(void* const* d_in, const int* in_sizes, int n_in, void* d_out, int out_size, void* d_ws, size_t ws_size, hipStream_t stream) {
    static int grid = 0;
    if (grid == 0) {
        if (n_in != 33 || ws_size < WS_END) { fprintf(stderr, "kernel_launch: need 33 inputs and %zu bytes of workspace; got %d, %zu\n", (size_t)WS_END, n_in, ws_size); grid = -1; return; }
        int dev = 0, cus = 0, per_cu = 0;
        hipGetDevice(&dev); hipDeviceGetAttribute(&cus, hipDeviceAttributeMultiprocessorCount, dev);
        hipFuncSetAttribute((const void*)mk_fwd, hipFuncAttributeMaxDynamicSharedMemorySize, LDS_BYTES);
        hipOccupancyMaxActiveBlocksPerMultiprocessor(&per_cu, (const void*)mk_fwd, NTHR, LDS_BYTES);
        (void)hipGetLastError();
        if (per_cu < 1) per_cu = 1;
        grid = cus;
        if (grid > 256) grid = 256;
    }
    if (grid < 0) return;
    (void)hipMemsetAsync((char*)d_ws + WS_BAR, 0, XCD_BAR_WORDS * 4, stream);
    Args a{};
    for (int i = 0; i < 33; ++i) a.in[i] = (const float*)d_in[i];
    a.out = (float*)d_out; a.ws = (unsigned char*)d_ws;
#if MK_N_LAUNCH_PER_PHASE
    for (int ph = 0; ph < NPHASES; ++ph) { a.lo = ph; a.hi = ph + 1; void* kargs[] = {&a};
        hipLaunchCooperativeKernel((const void*)mk_fwd, dim3(grid), dim3(NTHR), kargs, LDS_BYTES, stream); }
#else
    a.lo = 0; a.hi = NPHASES;
    void* kargs[] = {&a};
    hipError_t e = hipLaunchCooperativeKernel((const void*)mk_fwd, dim3(grid), dim3(NTHR), kargs, LDS_BYTES, stream);
    if (e != hipSuccess) fprintf(stderr, "cooperative launch failed: %s (grid %d)\n", hipGetErrorString(e), grid);
#endif
}
```

```cpp
#include <hip/hip_runtime.h>
#include <hip/hip_cooperative_groups.h>
#include <cstdio>
#include <cstdint>
namespace cg = cooperative_groups;

#define LAS __attribute__((address_space(3)))
typedef unsigned short bf16_t;
typedef short bf16x8 __attribute__((ext_vector_type(8)));
typedef float f32x4 __attribute__((ext_vector_type(4)));
typedef unsigned u32x4 __attribute__((ext_vector_type(4)));
typedef unsigned u32x2 __attribute__((ext_vector_type(2)));

#ifndef REP_GEMM
#define REP_GEMM 1
#endif
#ifndef REP_SCAN
#define REP_SCAN 1
#endif
#ifndef REP_ATTN
#define REP_ATTN 1
#endif
#ifndef REP_ELT
#define REP_ELT 1
#endif
#ifndef REP_SYNC
#define REP_SYNC 1
#endif
#ifndef MK_N_LAUNCH_PER_PHASE
#define MK_N_LAUNCH_PER_PHASE 0
#endif

constexpr int D = 1024, MTOK = 36864, MCTX = 4096, NCOND = 9, FF = 4096;
constexpr int NTHR = 512, NWAVES = 8;
constexpr size_t MiB = 1u << 20;
constexpr size_t O_STATE = 37748736, O_CK = 41943040, O_CV = 50331648;
constexpr size_t WS_MODV = 0;
constexpr size_t WS_CS = 1 * MiB;
constexpr size_t WS_WT = 6 * MiB;
constexpr size_t WS_ACT = 40 * MiB;
constexpr size_t TOKK = (size_t)MTOK * 1024;
constexpr size_t WS_END = WS_ACT + 13 * TOKK;
constexpr size_t WT_CAT = 0, WT_G2 = 14 * MiB, WT_W2S = 14 * MiB + 512 * 1024, WT_A2S = 14 * MiB + 768 * 1024, WT_WO = 15 * MiB, WT_W1 = 17 * MiB, WT_W2 = 25 * MiB;
constexpr size_t WT_QKV = 0;
constexpr size_t A_RKVL = 0, A_H2 = 7 * TOKK, A_G = 11 * TOKK;
constexpr size_t A_HN = 0, A_U = 2 * TOKK;
constexpr size_t A_QK = 2 * TOKK, A_VT = 6 * TOKK, A_CKB = 10 * TOKK, A_CVT = 10 * TOKK + 4 * MiB;
constexpr int LDR = 3584;
constexpr int LDS_BYTES = 147456;
constexpr int TAB_OFF = 146944;

__device__ __forceinline__ unsigned cvt_pk_bf16(float lo, float hi) { unsigned r; asm volatile("v_cvt_pk_bf16_f32 %0, %1, %2" : "=v"(r) : "v"(lo), "v"(hi)); return r; }
__device__ __forceinline__ float bf_lo(unsigned u) { return __uint_as_float(u << 16); }
__device__ __forceinline__ float bf_hi(unsigned u) { return __uint_as_float(u & 0xffff0000u); }
__device__ __forceinline__ float wave_sum(float v) {
#pragma unroll
    for (int o = 1; o < 64; o <<= 1) v += __shfl_xor(v, o);
    return v;
}
__device__ __forceinline__ float dpp_xor1(float x) { return __builtin_bit_cast(float, __builtin_amdgcn_update_dpp(0, __builtin_bit_cast(int, x), 0xB1, 0xF, 0xF, true)); }
__device__ __forceinline__ float dpp_xor2(float x) { return __builtin_bit_cast(float, __builtin_amdgcn_update_dpp(0, __builtin_bit_cast(int, x), 0x4E, 0xF, 0xF, true)); }
__device__ __forceinline__ float quad_sum(float x) { x += dpp_xor1(x); x += dpp_xor2(x); return x; }
__device__ __forceinline__ float dpp_hmirror(float x) { return __builtin_bit_cast(float, __builtin_amdgcn_update_dpp(0, __builtin_bit_cast(int, x), 0x141, 0xF, 0xF, true)); }
__device__ __forceinline__ float oct_sum(float x) { x += dpp_hmirror(x); x += dpp_xor1(x); x += dpp_xor2(x); return x; }
typedef float f32x2 __attribute__((ext_vector_type(2)));
template <int SH> __device__ __forceinline__ float dpp_row_shr_or1(float x) {
    return __builtin_bit_cast(float, __builtin_amdgcn_update_dpp(0x3f800000, __builtin_bit_cast(int, x), 0x110 + SH, 0xF, 0xF, false)); }
__device__ __forceinline__ float sigmoidf_(float x) { return __builtin_amdgcn_rcpf(1.0f + __expf(-x)); }
__device__ __forceinline__ float tanhf_(float x) { return 1.0f - 2.0f * __builtin_amdgcn_rcpf(1.0f + __expf(2.0f * x)); }
__device__ __forceinline__ int cond_of_row(int row) { return row < MCTX ? 0 : 1 + ((row - MCTX) >> 12); }

namespace pg8 {
constexpr int BM = 256, BK = 64, HALF = 128, HTB = HALF * BK * 2, STAGE_BYTES = 8 * HTB, NXCD = 8, WGM = 4;
__host__ __device__ __forceinline__ int lds_byte(int r, int c) { const int st = (r >> 4) * 2 + (c >> 5), rr = r & 15, cc = c & 31, ob = rr * 64 + cc * 2; return st * 1024 + (ob ^ (((ob >> 9) & 1) << 5)); }
__host__ __device__ __forceinline__ void stage_rc(int b, int& R, int& C) { const int st = b / 1024, sb = b % 1024, swz = sb ^ (((sb >> 9) & 1) << 5); R = (st >> 1) * 16 + swz / 64; C = (st & 1) * 32 + (swz % 64) / 2; }
struct Unit { int pm, pn; };
struct Gemm { const bf16_t* A; int lda; const bf16_t* Bt; int N, K; };
struct StaticOrder {
    int nM, nN, nwg, G, c, wgm;
    __device__ void init(int M, int N, int G_, int c_, int wgm_ = WGM) { nM = M / BM; nN = N / BM; nwg = nM * nN; G = G_; c = c_; wgm = wgm_; }
    __device__ bool next(int i, Unit& u) const {
        const long L = (long)i * G + c; if (L >= nwg) return false;
        int wgid = (int)L; { const int q = nwg / NXCD, r = nwg % NXCD, xcd = wgid % NXCD, off = wgid / NXCD; wgid = (xcd < r ? xcd * (q + 1) : r * (q + 1) + (xcd - r) * q) + off; }
        const int nig = wgm * nN, gid = wgid / nig, fm = gid * wgm, gsz = (nM - fm) < wgm ? (nM - fm) : wgm;
        u.pm = fm + ((wgid % nig) % gsz); u.pn = (wgid % nig) / gsz; return true;
    }
};
template <class Epi>
__device__ __forceinline__ void gemm_phase(LAS unsigned char* lds, const int tid, const Gemm g, const StaticOrder& S, const Epi& E) {
    const int wid = __builtin_amdgcn_readfirstlane(tid >> 6), lane = tid & 63, wr = wid >> 2, wc = wid & 3, fr = lane & 15, fq = lane >> 4;
    const int K = g.K, nt = K / BK, lda = g.lda;
    unsigned voffA[2], voffB[2];
#pragma unroll
    for (int i = 0; i < 2; ++i) { int R, C; stage_rc(tid * 16 + i * 8192, R, C); const int r32 = R & 31;
        const int Rb = 64 * (R >> 5) + (Epi::PERM ? (8 * ((r32 & 15) >> 2) + 4 * (r32 >> 4) + (r32 & 3)) : r32);
        voffA[i] = (unsigned)(R * lda + C) * 2u; voffB[i] = (unsigned)(Rb * K + C) * 2u; }
    const size_t kstep = (size_t)(BK * 2);
    const size_t hstepA = (size_t)HALF * lda * 2, tstepA = 2 * hstepA;
    const size_t hstepB = (size_t)32 * K * 2, tstepB = (size_t)256 * K * 2;
    const unsigned ldsw = (unsigned)wid * 1024u;
    const int aoff = lds_byte(wr * 64 + fr, fq * 8), boff = lds_byte(wc * 32 + fr, fq * 8);
#define PG8_SA(b, h) (((b) * 2 + (h)) * HTB)
#define PG8_SB(b, h) ((4 + (b) * 2 + (h)) * HTB)
#define PG8_STAGE(bufoff, gbase, voff) do { _Pragma("unroll") for (int _i = 0; _i < 2; ++_i) \
        __builtin_amdgcn_global_load_lds((const unsigned*)((const char*)(gbase) + (voff)[_i]), (LAS unsigned*)(lds + (bufoff) + ldsw + _i * 8192), 16, 0, 0); } while (0)
#define PG8_LDA(dst, b, h) do { _Pragma("unroll") for (int m = 0; m < 4; ++m) _Pragma("unroll") for (int k = 0; k < 2; ++k) dst[m][k] = *(const LAS bf16x8*)(lds + PG8_SA(b, h) + aoff + m * 2048 + k * 1024); } while (0)
#define PG8_LDB(dst, b, h) do { _Pragma("unroll") for (int n = 0; n < 2; ++n) _Pragma("unroll") for (int k = 0; k < 2; ++k) dst[n][k] = *(const LAS bf16x8*)(lds + PG8_SB(b, h) + boff + n * 2048 + k * 1024); } while (0)
#define PG8_MMA(ai, bj, At, Bt) do { __builtin_amdgcn_s_setprio(1); _Pragma("unroll") for (int m = 0; m < 4; ++m) _Pragma("unroll") for (int n = 0; n < 2; ++n) _Pragma("unroll") for (int k = 0; k < 2; ++k) \
        acc[ai][bj][m][n] = __builtin_amdgcn_mfma_f32_16x16x32_bf16(Bt[n][k], At[m][k], acc[ai][bj][m][n], 0, 0, 0); __builtin_amdgcn_s_setprio(0); } while (0)
#define PG8_WAIT_V(n) asm volatile("s_waitcnt vmcnt(" #n ")" ::: "memory")
#define PG8_WAIT_L(n) asm volatile("s_waitcnt lgkmcnt(" #n ")" ::: "memory")
#define PG8_BAR __builtin_amdgcn_s_barrier()
#define PG8_SCHED __builtin_amdgcn_sched_barrier(0)
    Unit cur, nxt; int ui = 0;
    if (!S.next(0, cur)) return;
    f32x4 acc[2][2][4][2];
#pragma unroll
    for (int a = 0; a < 2; ++a)
#pragma unroll
        for (int b = 0; b < 2; ++b)
#pragma unroll
            for (int m = 0; m < 4; ++m)
#pragma unroll
                for (int n = 0; n < 2; ++n) acc[a][b][m][n] = (f32x4){0.f, 0.f, 0.f, 0.f};
    bf16x8 At[4][2], B0[2][2], B1[2][2];
    const char* cA = (const char*)g.A + (size_t)cur.pm * tstepA; const char* cB = (const char*)g.Bt + (size_t)cur.pn * tstepB;
    PG8_STAGE(PG8_SB(0, 0), cB, voffB); PG8_STAGE(PG8_SB(0, 1), cB + hstepB, voffB); PG8_STAGE(PG8_SA(0, 0), cA, voffA); PG8_STAGE(PG8_SA(0, 1), cA + hstepA, voffA);
    if (wr == 1) PG8_BAR;
    PG8_WAIT_V(2); PG8_BAR;
    PG8_STAGE(PG8_SB(1, 0), cB + kstep, voffB); PG8_STAGE(PG8_SA(1, 0), cA + kstep, voffA); PG8_STAGE(PG8_SB(1, 1), cB + hstepB + kstep, voffB);
    PG8_WAIT_V(6); PG8_BAR;
    for (;;) {
        const bool has_next = S.next(ui + 1, nxt);
        const char* nA = has_next ? (const char*)g.A + (size_t)nxt.pm * tstepA : cA; const char* nB = has_next ? (const char*)g.Bt + (size_t)nxt.pn * tstepB : cB;
        for (int t = 0; t < nt; t += 2) {
            const bool last = (t == nt - 2);
            const char* a1 = cA + (size_t)(t + 1) * kstep;
            const char* a2 = last ? nA : cA + (size_t)(t + 2) * kstep; const char* b2 = last ? nB : cB + (size_t)(t + 2) * kstep;
            const char* a3 = a2 + kstep; const char* b3 = b2 + kstep;
            PG8_LDB(B0, 0, 0); PG8_LDB(B1, 0, 1); PG8_SCHED; PG8_LDA(At, 0, 0); PG8_STAGE(PG8_SA(1, 1), a1 + hstepA, voffA);
            PG8_WAIT_V(8); PG8_WAIT_L(0); PG8_BAR; PG8_MMA(0, 0, At, B0); PG8_MMA(0, 1, At, B1); PG8_BAR; PG8_SCHED;
            PG8_LDA(At, 0, 1); PG8_STAGE(PG8_SB(0, 0), b2, voffB); PG8_STAGE(PG8_SB(0, 1), b2 + hstepB, voffB); PG8_STAGE(PG8_SA(0, 0), a2, voffA);
            PG8_WAIT_V(8); PG8_WAIT_L(0); PG8_BAR; PG8_MMA(1, 0, At, B0); PG8_MMA(1, 1, At, B1); PG8_BAR; PG8_SCHED;
            PG8_LDB(B0, 1, 0); PG8_LDB(B1, 1, 1); PG8_SCHED; PG8_LDA(At, 1, 0); PG8_STAGE(PG8_SA(0, 1), a2 + hstepA, voffA);
            PG8_WAIT_V(8); PG8_WAIT_L(0); PG8_BAR; PG8_MMA(0, 0, At, B0); PG8_MMA(0, 1, At, B1); PG8_BAR; PG8_SCHED;
            PG8_LDA(At, 1, 1); PG8_STAGE(PG8_SB(1, 0), b3, voffB); PG8_STAGE(PG8_SB(1, 1), b3 + hstepB, voffB); PG8_STAGE(PG8_SA(1, 0), a3, voffA);
            PG8_WAIT_V(8); PG8_WAIT_L(0); PG8_BAR; PG8_MMA(1, 0, At, B0); PG8_MMA(1, 1, At, B1); PG8_BAR; PG8_SCHED;
        }
        if (wr == 0) PG8_BAR;
        E(acc, cur, wr, wc, fr, fq);
        if (!has_next) break;
#pragma unroll
        for (int a = 0; a < 2; ++a)
#pragma unroll
            for (int b = 0; b < 2; ++b)
#pragma unroll
                for (int m = 0; m < 4; ++m)
#pragma unroll
                    for (int n = 0; n < 2; ++n) acc[a][b][m][n] = (f32x4){0.f, 0.f, 0.f, 0.f};
        cur = nxt; cA = nA; cB = nB; ++ui;
        if (wr == 1) PG8_BAR;
    }
    PG8_WAIT_V(0);
    PG8_BAR;
#undef PG8_SA
#undef PG8_SB
#undef PG8_STAGE
#undef PG8_LDA
#undef PG8_LDB
#undef PG8_MMA
#undef PG8_WAIT_V
#undef PG8_WAIT_L
#undef PG8_BAR
#undef PG8_SCHED
}

typedef f32x4 Acc[2][2][4][2];
struct EpiRKVL {
    static constexpr bool PERM = true;
    bf16_t* O; const float* kkg;
    __device__ __forceinline__ void operator()(const Acc& acc, const Unit& u, int wr, int wc, int fr, int fq) const {
        const int act = (u.pn == 12 && wc < 2) ? 1 : ((u.pn == 13 && wc < 2) ? 2 : 0);
        if (u.pn == 13 && wc >= 2) return;
        const int row0 = u.pm * BM + wr * 64 + fr, col0 = u.pn * BM + wc * 64 + 8 * fq;
        if (u.pn >= 4 && u.pn < 8) {
            const int hh = ((u.pn - 4) << 2) + wc; const float* gq = kkg + hh * 64 + 8 * fq;
            f32x4 kg[2][2];
#pragma unroll
            for (int bj = 0; bj < 2; ++bj)
#pragma unroll
                for (int n = 0; n < 2; ++n) kg[bj][n] = *(const f32x4*)(gq + bj * 32 + n * 4);
#pragma unroll
            for (int ai = 0; ai < 2; ++ai)
#pragma unroll
                for (int m = 0; m < 4; ++m) { float ss = 0.f;
#pragma unroll
                    for (int bj = 0; bj < 2; ++bj)
#pragma unroll
                        for (int n = 0; n < 2; ++n) { const f32x4 v = acc[ai][bj][m][n] * kg[bj][n]; ss += (v[0] * v[0] + v[1] * v[1]) + (v[2] * v[2] + v[3] * v[3]); }
                    ss += __shfl_xor(ss, 16); ss += __shfl_xor(ss, 32);
                    if (fq == 0) ((float*)(O + (size_t)(row0 + ai * HALF + m * 16) * LDR + 3456))[hh] = __builtin_amdgcn_rcpf(ss + 1e-12f); }
        }
#pragma unroll
        for (int ai = 0; ai < 2; ++ai)
#pragma unroll
            for (int m = 0; m < 4; ++m) { bf16_t* rowp = O + (size_t)(row0 + ai * HALF + m * 16) * LDR + col0;
#pragma unroll
                for (int bj = 0; bj < 2; ++bj) { u32x4 w;
#pragma unroll
                    for (int n = 0; n < 2; ++n) { f32x4 v = acc[ai][bj][m][n];
                        if (act == 1) { v[0] = tanhf_(v[0]); v[1] = tanhf_(v[1]); v[2] = tanhf_(v[2]); v[3] = tanhf_(v[3]); }
                        if (act == 2) { v[0] = sigmoidf_(v[0]); v[1] = sigmoidf_(v[1]); v[2] = sigmoidf_(v[2]); v[3] = sigmoidf_(v[3]); }
                        w[2 * n] = cvt_pk_bf16(v[0], v[1]); w[2 * n + 1] = cvt_pk_bf16(v[2], v[3]); }
                    *(u32x4*)(rowp + bj * 32) = w; } }
    }
};
template <int ACT> struct EpiBf16 {
    static constexpr bool PERM = true;
    bf16_t* O; int ldc;
    __device__ __forceinline__ void operator()(const Acc& acc, const Unit& u, int wr, int wc, int fr, int fq) const {
        const int row0 = u.pm * BM + wr * 64 + fr, col0 = u.pn * BM + wc * 64 + 8 * fq;
#pragma unroll
        for (int ai = 0; ai < 2; ++ai)
#pragma unroll
            for (int m = 0; m < 4; ++m) { bf16_t* rowp = O + (size_t)(row0 + ai * HALF + m * 16) * ldc + col0;
#pragma unroll
                for (int bj = 0; bj < 2; ++bj) { u32x4 w;
#pragma unroll
                    for (int n = 0; n < 2; ++n) { f32x4 v = acc[ai][bj][m][n];
                        if (ACT == 1) { v[0] = fmaxf(v[0], 0.f); v[1] = fmaxf(v[1], 0.f); v[2] = fmaxf(v[2], 0.f); v[3] = fmaxf(v[3], 0.f); v = v * v; }
                        w[2 * n] = cvt_pk_bf16(v[0], v[1]); w[2 * n + 1] = cvt_pk_bf16(v[2], v[3]); }
                    *(u32x4*)(rowp + bj * 32) = w; } }
    }
};
template <bool FIRST> struct EpiRes {
    static constexpr bool PERM = false;
    float* X; const float* gate; float gs; LAS unsigned char* tab;
    __device__ __forceinline__ void operator()(const Acc& acc, const Unit& u, int wr, int wc, int fr, int fq) const {
        const int cond = u.pm < 16 ? 0 : 1 + ((u.pm - 16) >> 4);
        const int row0 = u.pm * BM + wr * 64 + fr, col0 = u.pn * BM + wc * 64 + 4 * fq;
        const float* gp = gate + (size_t)cond * 6144 + col0;
        f32x4 gv[2][2];
#pragma unroll
        for (int bj = 0; bj < 2; ++bj)
#pragma unroll
            for (int n = 0; n < 2; ++n) gv[bj][n] = *(const f32x4*)(gp + bj * 32 + n * 16) * gs;
#pragma unroll
        for (int ai = 0; ai < 2; ++ai)
#pragma unroll
            for (int m = 0; m < 4; ++m) { const size_t ro = (size_t)(row0 + ai * HALF + m * 16) * D + col0; float* rowp = X + ro;
                const float* srcp = rowp;
                if (FIRST) { const LAS unsigned* t = (const LAS unsigned*)tab + (u.pm < 16 ? 0 : 2); const unsigned lo = __builtin_amdgcn_readfirstlane(t[0]), hi = __builtin_amdgcn_readfirstlane(t[1]);
                    srcp = (const float*)(__attribute__((address_space(1))) const unsigned char*)(((unsigned long long)hi << 32) | lo) + (u.pm < 16 ? ro : ro - (size_t)MCTX * D); }
#pragma unroll
                for (int bj = 0; bj < 2; ++bj)
#pragma unroll
                    for (int n = 0; n < 2; ++n) { f32x4 x = *(const f32x4*)(srcp + bj * 32 + n * 16); x = x + gv[bj][n] * acc[ai][bj][m][n]; *(f32x4*)(rowp + bj * 32 + n * 16) = x; }
                asm volatile("" ::: "memory"); }
    }
};
struct EpiQKV {
    static constexpr bool PERM = true;
    bf16_t* QK; bf16_t* VT; const float* qg; const float* kg; float* out_k; float* out_v; int li;
    __device__ __forceinline__ void operator()(const Acc& acc, const Unit& u, int wr, int wc, int fr, int fq) const {
        const int which = u.pn >> 2, hh = ((u.pn & 3) << 2) + wc;
        const int row0 = u.pm * BM + wr * 64 + fr;
        const bool ctx = u.pm < 16;
        if (which < 2) {
            const float* gp = (which == 0 ? qg : kg) + 8 * fq;
            f32x4 gv[2][2];
#pragma unroll
            for (int bj = 0; bj < 2; ++bj)
#pragma unroll
                for (int n = 0; n < 2; ++n) gv[bj][n] = *(const f32x4*)(gp + bj * 32 + n * 4);
#pragma unroll
            for (int ai = 0; ai < 2; ++ai)
#pragma unroll
                for (int m = 0; m < 4; ++m) {
                    float ss = 0.f;
#pragma unroll
                    for (int bj = 0; bj < 2; ++bj)
#pragma unroll
                        for (int n = 0; n < 2; ++n) { const f32x4 v = acc[ai][bj][m][n]; ss += (v[0] * v[0] + v[1] * v[1]) + (v[2] * v[2] + v[3] * v[3]); }
                    ss += __shfl_xor(ss, 16); ss += __shfl_xor(ss, 32);
                    const float rinv = rsqrtf(ss * (1.0f / 64.0f) + 1e-6f);
                    const int row = row0 + ai * HALF + m * 16;
                    bf16_t* rowp = QK + (size_t)row * 2048 + which * 1024 + hh * 64 + 8 * fq;
                    float* op = out_k + ((size_t)((u.pm * 2 + li) * 16 + hh) * 256 + (row & 255)) * 64 + 8 * fq;
#pragma unroll
                    for (int bj = 0; bj < 2; ++bj) { u32x4 w;
#pragma unroll
                        for (int n = 0; n < 2; ++n) { f32x4 v = acc[ai][bj][m][n] * rinv * gv[bj][n];
                            w[2 * n] = cvt_pk_bf16(v[0], v[1]); w[2 * n + 1] = cvt_pk_bf16(v[2], v[3]);
                            if (which == 1 && ctx) *(f32x4*)(op + bj * 32 + n * 4) = v; }
                        *(u32x4*)(rowp + bj * 32) = w; }
                }
        } else {
#pragma unroll
            for (int ai = 0; ai < 2; ++ai)
#pragma unroll
                for (int m = 0; m < 4; ++m) {
                    const int row = row0 + ai * HALF + m * 16;
                    float* op = out_v + ((size_t)((u.pm * 2 + li) * 16 + hh) * 256 + (row & 255)) * 64 + 8 * fq;
#pragma unroll
                    for (int bj = 0; bj < 2; ++bj)
#pragma unroll
                        for (int n = 0; n < 2; ++n) { const f32x4 v = acc[ai][bj][m][n];
                            bf16_t* vp = VT + (size_t)(hh * 64 + bj * 32 + 8 * fq + 4 * n) * MTOK + row;
                            const unsigned w0 = cvt_pk_bf16(v[0], v[1]), w1 = cvt_pk_bf16(v[2], v[3]);
                            vp[0] = (bf16_t)(w0 & 0xffff); vp[MTOK] = (bf16_t)(w0 >> 16); vp[2 * (size_t)MTOK] = (bf16_t)(w1 & 0xffff); vp[3 * (size_t)MTOK] = (bf16_t)(w1 >> 16);
                            if (ctx) *(f32x4*)(op + bj * 32 + n * 4) = v; }
                }
        }
    }
};
}

struct Args { const float* in[33]; float* out; unsigned char* ws; int lo, hi; };

struct Frame {
    LAS unsigned char* lds;
    int tid, lane, wave, G, bid;
    mutable int rot;
    int cbid, cG;
    float* out; unsigned char* ws;
};

__device__ __forceinline__ const float* IN(const Frame& F, int k) {
    const LAS unsigned* t = (const LAS unsigned*)(F.lds + TAB_OFF) + 2 * k; unsigned lo = t[0], hi = t[1];
    lo = __builtin_amdgcn_readfirstlane(lo); hi = __builtin_amdgcn_readfirstlane(hi); return (const float*)(__attribute__((address_space(1))) const unsigned char*)(((unsigned long long)hi << 32) | lo);
}
__device__ __forceinline__ void conv_t(const Frame& F, const float* W0, int K, int N, bf16_t* dst0, int ldd, int dcol0, const float* scale, int nbatch = 1, size_t sstride = 0, size_t dstride = 0) {
    LAS float* scr = (LAS float*)(F.lds + F.wave * 8704);
    const int lane = F.lane, NGW = F.cG * NWAVES;
    const int nblk = N / 32, nitems1 = (K / 64) * nblk, nitems = nitems1 * nbatch;
    int gw = F.cbid * NWAVES + F.wave - F.rot; if (gw < 0) gw += NGW;
    F.rot = (F.rot + nitems) % NGW;
    for (int it0 = gw; it0 < nitems; it0 += NGW) {
        const int bt = it0 / nitems1, it = it0 % nitems1; const float* W = W0 + (size_t)bt * sstride; bf16_t* dst = dst0 + (size_t)bt * dstride;
        const int kb = it / nblk, nb = it % nblk, k0 = 64 * kb, n0 = 32 * nb;
#pragma unroll 8
        for (int i = 0; i < 32; ++i) { const int kk = 2 * i + (lane >> 5); float v = W[(size_t)(k0 + kk) * N + n0 + (lane & 31)]; if (scale) v *= scale[k0 + kk]; scr[kk * 33 + (lane & 31)] = v; }
        asm volatile("s_waitcnt lgkmcnt(0)" ::: "memory");
        const int c = lane & 7;
#pragma unroll
        for (int j = 0; j < 4; ++j) { const int n = (lane >> 3) + 8 * j; const LAS float* s = scr + (8 * c) * 33 + n;
            u32x4 o; o.x = cvt_pk_bf16(s[0 * 33], s[1 * 33]); o.y = cvt_pk_bf16(s[2 * 33], s[3 * 33]); o.z = cvt_pk_bf16(s[4 * 33], s[5 * 33]); o.w = cvt_pk_bf16(s[6 * 33], s[7 * 33]);
            *(u32x4*)(dst + (size_t)(n0 + n) * ldd + dcol0 + k0 + 8 * c) = o; }
        asm volatile("s_waitcnt lgkmcnt(0)" ::: "memory");
    }
}
__device__ __forceinline__ void zero_bytes_c(const Frame& F, void* p, size_t nbytes) {
    u32x4* q = (u32x4*)p; const size_t n = nbytes / 16; unsigned z = 0; asm volatile("" : "+v"(z));
    for (size_t i = (size_t)F.cbid * NTHR + F.tid; i < n; i += (size_t)F.cG * NTHR) q[i] = (u32x4){z, z, z, z};
}
__device__ __forceinline__ void zero_bytes(const Frame& F, void* p, size_t nbytes) {
    u32x4* q = (u32x4*)p; const size_t n = nbytes / 16; unsigned z = 0; asm volatile("" : "+v"(z));
    for (size_t i = (size_t)F.bid * NTHR + F.tid; i < n; i += (size_t)F.G * NTHR) q[i] = (u32x4){z, z, z, z};
}

__device__ __forceinline__ void norm_row(const float* xrow, const float* g, const float* sc, const float* sh, int lane, f32x4 (&h)[4]) {
    float s = 0.f;
#pragma unroll
    for (int jx = 0; jx < 4; ++jx) { h[jx] = *(const f32x4*)(xrow + 4 * lane + 256 * jx); s += (h[jx][0] * h[jx][0] + h[jx][1] * h[jx][1]) + (h[jx][2] * h[jx][2] + h[jx][3] * h[jx][3]); }
    const float rinv = rsqrtf(wave_sum(s) * (1.0f / 1024.0f) + 1e-6f);
#pragma unroll
    for (int jx = 0; jx < 4; ++jx) { const f32x4 gg = *(const f32x4*)(g + 4 * lane + 256 * jx), ss = *(const f32x4*)(sc + 4 * lane + 256 * jx), hh = *(const f32x4*)(sh + 4 * lane + 256 * jx);
        h[jx] = h[jx] * rinv * gg * (ss + 1.0f) + hh; }
}

template <int NR>
__device__ __forceinline__ void norm_rows(const float* x0, unsigned vmask, const float* g, const float* sc, const float* sh, int lane, f32x4 (&h)[NR][4]) {
    float s[NR];
#pragma unroll
    for (int r = 0; r < NR; ++r) { s[r] = 0.f;
#pragma unroll
        for (int jx = 0; jx < 4; ++jx) h[r][jx] = ((vmask >> r) & 1u) ? *(const f32x4*)(x0 + (size_t)r * D + 4 * lane + 256 * jx) : (f32x4){0.f, 0.f, 0.f, 0.f}; }
    f32x4 gm[4], hh[4];
#pragma unroll
    for (int jx = 0; jx < 4; ++jx) { const f32x4 gg = *(const f32x4*)(g + 4 * lane + 256 * jx), ss = *(const f32x4*)(sc + 4 * lane + 256 * jx); hh[jx] = *(const f32x4*)(sh + 4 * lane + 256 * jx); gm[jx] = gg * (ss + 1.0f); }
#pragma unroll
    for (int r = 0; r < NR; ++r)
#pragma unroll
        for (int jx = 0; jx < 4; ++jx) s[r] += (h[r][jx][0] * h[r][jx][0] + h[r][jx][1] * h[r][jx][1]) + (h[r][jx][2] * h[r][jx][2] + h[r][jx][3] * h[r][jx][3]);
#pragma unroll
    for (int o = 1; o < 64; o <<= 1) {
#pragma unroll
        for (int r = 0; r < NR; ++r) s[r] += __shfl_xor(s[r], o); }
#pragma unroll
    for (int r = 0; r < NR; ++r) { const float rinv = rsqrtf(s[r] * (1.0f / 1024.0f) + 1e-6f); const bool ok = (vmask >> r) & 1u;
#pragma unroll
        for (int jx = 0; jx < 4; ++jx) h[r][jx] = ok ? h[r][jx] * rinv * gm[jx] + hh[jx] : (f32x4){0.f, 0.f, 0.f, 0.f}; }
}

__device__ __forceinline__ void phase_p0(const Frame& F) {
    LAS float* sl = (LAS float*)F.lds;
    LAS float* red = (LAS float*)(F.lds + 36864);
    const float* c = IN(F, 5); const float* cctx = IN(F, 6);
    for (int i = F.tid; i < NCOND * 1024; i += NTHR) { const int cb = i >> 10, d = i & 1023; const float v = cb == 0 ? cctx[d] : c[(cb - 1) * 1024 + d]; sl[i] = v / (1.0f + __expf(-v)); }
    __syncthreads();
    float* modv = (float*)(F.ws + WS_MODV);
    const int dg = F.tid >> 4, c4 = F.tid & 15;
    for (int it = F.bid; it < 4 * 96; it += F.G) {
        const int l = it / 96, ch = it % 96;
        const float* W = IN(F, 8) + (size_t)l * 1024 * 6144 + ch * 64 + 4 * c4;
        f32x4 acc[NCOND];
#pragma unroll
        for (int cb = 0; cb < NCOND; ++cb) acc[cb] = (f32x4){0.f, 0.f, 0.f, 0.f};
#pragma unroll 8
        for (int dd = 0; dd < 32; ++dd) { const int d = dg * 32 + dd; const f32x4 wv = *(const f32x4*)(W + (size_t)d * 6144);
#pragma unroll
            for (int cb = 0; cb < NCOND; ++cb) acc[cb] += wv * sl[cb * 1024 + d]; }
#pragma unroll
        for (int cb = 0; cb < NCOND; ++cb) *(LAS f32x4*)(red + (dg * NCOND + cb) * 64 + 4 * c4) = acc[cb];
        __syncthreads();
        for (int o = F.tid; o < NCOND * 64; o += NTHR) { const int cb = o >> 6, cc = o & 63; float s = 0.f;
#pragma unroll 8
            for (int gq = 0; gq < 32; ++gq) s += red[(gq * NCOND + cb) * 64 + cc];
            const int col = ch * 64 + cc;
            modv[((size_t)(l * NCOND + cb)) * 6144 + col] = s + IN(F, 9)[l * 6144 + col]; }
        __syncthreads();
    }
}

__device__ __forceinline__ void conv_w2(const Frame& F, int l) { conv_t(F, IN(F, 11) + (size_t)l * FF * D, FF, D, (bf16_t*)(F.ws + WS_WT + WT_W2), FF, 0, nullptr); }
__device__ __forceinline__ void conv_mlp(const Frame& F, int l) {
    conv_t(F, IN(F, 10) + (size_t)l * D * FF, D, FF, (bf16_t*)(F.ws + WS_WT + WT_W1), D, 0, nullptr);
}
__device__ __forceinline__ void conv_rwkv(const Frame& F, int l) {
    const int i = l >> 1;
    bf16_t* cat = (bf16_t*)(F.ws + WS_WT + WT_CAT);
    const float* mu = IN(F, 12) + (size_t)i * 6 * D;
    for (int j = 0; j < 3; ++j) { const float* W = IN(F, 13) + ((size_t)i * 3 + j) * D * D;
        conv_t(F, W, D, D, cat + (size_t)j * 1024 * 2048, 2048, 0, nullptr);
        conv_t(F, W, D, D, cat + (size_t)j * 1024 * 2048, 2048, 1024, mu + j * D); }
    for (int d = 0; d < 2; ++d) {
        const float* W1 = IN(F, 16) + ((size_t)i * 2 + d) * D * 64; const float* A1 = IN(F, 19) + ((size_t)i * 2 + d) * D * 64;
        conv_t(F, W1, D, 64, cat + (size_t)(3072 + 64 * d) * 2048, 2048, 0, nullptr); conv_t(F, W1, D, 64, cat + (size_t)(3072 + 64 * d) * 2048, 2048, 1024, mu + 3 * D);
        conv_t(F, A1, D, 64, cat + (size_t)(3200 + 64 * d) * 2048, 2048, 0, nullptr); conv_t(F, A1, D, 64, cat + (size_t)(3200 + 64 * d) * 2048, 2048, 1024, mu + 4 * D);
        conv_t(F, IN(F, 17) + ((size_t)i * 2 + d) * 64 * D, 64, D, (bf16_t*)(F.ws + WS_WT + WT_W2S) + (size_t)d * 1024 * 64, 64, 0, nullptr);
        conv_t(F, IN(F, 20) + ((size_t)i * 2 + d) * 64 * D, 64, D, (bf16_t*)(F.ws + WS_WT + WT_A2S) + (size_t)d * 1024 * 64, 64, 0, nullptr);
    }
    { const float* G1 = IN(F, 21) + (size_t)i * D * 128;
      conv_t(F, G1, D, 128, cat + (size_t)3328 * 2048, 2048, 0, nullptr); conv_t(F, G1, D, 128, cat + (size_t)3328 * 2048, 2048, 1024, mu + 5 * D); }
    zero_bytes_c(F, cat + (size_t)3456 * 2048, (size_t)128 * 2048 * 2);
    bf16_t* g2t = (bf16_t*)(F.ws + WS_WT + WT_G2);
    conv_t(F, IN(F, 22) + (size_t)i * 128 * D, 128, D, g2t, 128, 0, nullptr);
    conv_t(F, IN(F, 14) + (size_t)i * D * D, D, D, (bf16_t*)(F.ws + WS_WT + WT_WO), D, 0, nullptr);
    conv_mlp(F, l);
}
__device__ __forceinline__ void conv_na(const Frame& F, int l) {
    const int i = l >> 1;
    conv_t(F, IN(F, 28) + (size_t)i * D * 3072, D, 3072, (bf16_t*)(F.ws + WS_WT + WT_QKV), D, 0, nullptr);
    conv_t(F, IN(F, 29) + (size_t)i * D * D, D, D, (bf16_t*)(F.ws + WS_WT + WT_WO), D, 0, nullptr);
    conv_mlp(F, l);
    bf16_t* ckb = (bf16_t*)(F.ws + WS_ACT + A_CKB); bf16_t* cvt = (bf16_t*)(F.ws + WS_ACT + A_CVT);
    for (int e = F.cbid * NTHR + F.tid; e < 8 * 16 * 256 * 64 / 4; e += F.cG * NTHR) {
        const int b = e / (16 * 256 * 16), r = e % (16 * 256 * 16);
        const f32x4 v = *(const f32x4*)(IN(F, 3) + ((size_t)(b * 2 + i) * 16 * 256 * 64) + (size_t)r * 4);
        u32x2 w; w.x = cvt_pk_bf16(v[0], v[1]); w.y = cvt_pk_bf16(v[2], v[3]);
        *(u32x2*)(ckb + (size_t)b * 16 * 256 * 64 + (size_t)r * 4) = w; }
    for (int b = 0; b < 8; ++b)
        conv_t(F, IN(F, 4) + ((size_t)((b * 2 + i) * 16)) * 256 * 64, 256, 64, cvt + (size_t)b * 16 * 64 * 256, 256, 0, nullptr, 16, (size_t)256 * 64, (size_t)64 * 256);
}

__device__ __forceinline__ void phase_norm(const Frame& F, int l, int which) {
    const float* modv = (const float*)(F.ws + WS_MODV) + (size_t)l * NCOND * 6144;
    const float* g = IN(F, 7) + (size_t)(l * 2 + which) * D;
    bf16_t* HN = (bf16_t*)(F.ws + WS_ACT + A_HN);
    const int gw = F.bid * NWAVES + F.wave, NGW = F.G * NWAVES, lane = F.lane;
    for (int row = 2 * gw; row < MTOK; row += 2 * NGW) {
        const float* mv = modv + (size_t)cond_of_row(row) * 6144 + which * 3 * 1024;
        f32x4 h[2][4]; norm_rows<2>(F.out + (size_t)row * D, 3u, g, mv + 1024, mv, lane, h);
#pragma unroll
        for (int r = 0; r < 2; ++r)
#pragma unroll
            for (int jx = 0; jx < 4; ++jx) { u32x2 w; w.x = cvt_pk_bf16(h[r][jx][0], h[r][jx][1]); w.y = cvt_pk_bf16(h[r][jx][2], h[r][jx][3]); *(u32x2*)(HN + (size_t)(row + r) * D + 4 * lane + 256 * jx) = w; }
    }
}
__device__ __forceinline__ void phase_pre_rwkv(const Frame& F, int l) {
    const float* modv = (const float*)(F.ws + WS_MODV) + (size_t)l * NCOND * 6144;
    const float* g = IN(F, 7) + (size_t)(l * 2) * D;
    bf16_t* H2 = (bf16_t*)(F.ws + WS_ACT + A_H2);
    const int gw = F.bid * NWAVES + F.wave, NGW = F.G * NWAVES, lane = F.lane;
    for (int row = 2 * gw; row < MTOK; row += 2 * NGW) {
        const float* mv = modv + (size_t)cond_of_row(row) * 6144;
        int t, T; if (row < MCTX) { t = row & 255; T = 256; } else { t = (row - MCTX) & 4095; T = 4096; }
        const unsigned vmask = (t > 0 ? 1u : 0u) | 6u | (t + 2 < T ? 8u : 0u);
        const float* xsrc = l == 0 ? (row < MCTX ? IN(F, 0) + (size_t)row * D : IN(F, 1) + (size_t)(row - MCTX) * D) : F.out + (size_t)row * D;
        f32x4 h[4][4]; norm_rows<4>(xsrc - D, vmask, g, mv + 1024, mv, lane, h);
#pragma unroll
        for (int r = 0; r < 2; ++r)
#pragma unroll
            for (int jx = 0; jx < 4; ++jx) { const f32x4 hc = h[r + 1][jx], dl = (h[r][jx] + h[r + 2][jx]) * 0.5f - hc;
                u32x2 w; w.x = cvt_pk_bf16(hc[0], hc[1]); w.y = cvt_pk_bf16(hc[2], hc[3]); *(u32x2*)(H2 + (size_t)(row + r) * 2048 + 4 * lane + 256 * jx) = w;
                u32x2 w2; w2.x = cvt_pk_bf16(dl[0], dl[1]); w2.y = cvt_pk_bf16(dl[2], dl[3]); *(u32x2*)(H2 + (size_t)(row + r) * 2048 + 1024 + 4 * lane + 256 * jx) = w2; }
    }
}

constexpr int SC_ST = 388;
constexpr int SC_BUF = 16 * SC_ST * 4;
constexpr int SC_GRP = 2 * SC_BUF + 1024 + 256 + 16384;
__device__ __forceinline__ void phase_scan(const Frame& F, int l, float yscale) {
    const int i = l >> 1, lane = F.lane;
    const int grp = F.wave >> 2, w = F.wave & 3;
    LAS unsigned char* gl = F.lds + grp * SC_GRP;
    LAS float* part = (LAS float*)(gl + 2 * SC_BUF);
    LAS float* rin = (LAS float*)(gl + 2 * SC_BUF + 1024) + w * 16;
    LAS float* ybuf = (LAS float*)(gl + 2 * SC_BUF + 1280) + w * 1024;
    const bf16_t* RK = (const bf16_t*)(F.ws + WS_ACT + A_RKVL);
    float* Y = (float*)(F.ws + WS_ACT + A_H2);
    float* CS = (float*)(F.ws + WS_CS);
    const int nitems = grp == 0 ? 256 : 512, cpi = grp == 0 ? 256 : 16;
    int nmine = 0; for (int it = F.bid; it < nitems; it += F.G) ++nmine;
    int nother = 0; { const int ni2 = grp == 0 ? 512 : 256; for (int it = F.bid; it < ni2; it += F.G) ++nother; }
    const int nb_mine = nmine * (1 + cpi), nb_oth = nother * (1 + (grp == 0 ? 16 : 256));
    const int pn = lane & 15, g4 = lane >> 4, dbase = 16 * w + 4 * g4;
    const int oc = lane & 7, pr = lane >> 3, vrow = 16 * w + 2 * pr;
    int par = 0;
#define SC_BAR() do { asm volatile("s_waitcnt lgkmcnt(0)" ::: "memory"); __builtin_amdgcn_s_barrier(); asm volatile("" ::: "memory"); } while (0)
    for (int item = F.bid; item < nitems; item += F.G) {
        const int b = item >> 5, h = (item >> 1) & 15, dir = item & 1;
        const int base_row = grp == 0 ? MCTX + b * 4096 : b * 256, T = grp == 0 ? 4096 : 256;
        f32x2 S0[4], S1[4];
        if (grp == 0) { const float* sp = IN(F, 2) + ((size_t)(((b * 2 + i) * 2 + dir) * 16 + h)) * 4096 + vrow * 64 + 8 * oc;
#pragma unroll
            for (int e2 = 0; e2 < 2; ++e2) { const f32x4 v0 = *(const f32x4*)(sp + 4 * e2), v1 = *(const f32x4*)(sp + 64 + 4 * e2);
                S0[2 * e2] = (f32x2){v0[0], v0[1]}; S0[2 * e2 + 1] = (f32x2){v0[2], v0[3]}; S1[2 * e2] = (f32x2){v1[0], v1[1]}; S1[2 * e2 + 1] = (f32x2){v1[2], v1[3]}; }
        } else {
#pragma unroll
            for (int e = 0; e < 4; ++e) { S0[e] = (f32x2){0.f, 0.f}; S1[e] = (f32x2){0.f, 0.f}; } }
        const bf16_t* wp = (const bf16_t*)(F.ws + WS_WT + WT_W2S) + ((size_t)dir * 1024 + h * 64 + 16 * w + pn) * 64 + 8 * g4;
        const bf16_t* ap = (const bf16_t*)(F.ws + WS_WT + WT_A2S) + ((size_t)dir * 1024 + h * 64 + 16 * w + pn) * 64 + 8 * g4;
        const bf16x8 ww0 = *(const bf16x8*)wp, ww1 = *(const bf16x8*)(wp + 32), wa0 = *(const bf16x8*)ap, wa1 = *(const bf16x8*)(ap + 32);
        const int dc = h * 64 + dbase;
        const f32x4 w0v = *(const f32x4*)(IN(F, 15) + (size_t)(i * 2 + dir) * D + dc), a0v = *(const f32x4*)(IN(F, 18) + (size_t)(i * 2 + dir) * D + dc);
        const f32x4 kkv = *(const f32x4*)(IN(F, 23) + (size_t)i * D + dc), kav = *(const f32x4*)(IN(F, 24) + (size_t)i * D + dc), rkv = *(const f32x4*)(IN(F, 25) + (size_t)i * D + dc);
        u32x2 ld_k, ld_r, ld_v; bf16x8 lw0, lw1, la0, la1; float ld_ri;
#define SC_PREFETCH(cc) do { const int s0_ = 16 * (cc) + pn; const int t0_ = dir == 0 ? s0_ : T - 1 - s0_; const bf16_t* rp_ = RK + (size_t)(base_row + t0_) * LDR; \
            ld_r = *(const u32x2*)(rp_ + dc); ld_k = *(const u32x2*)(rp_ + 1024 + dc); ld_v = *(const u32x2*)(rp_ + 2048 + dc); ld_ri = ((const float*)(rp_ + 3456))[h]; \
            lw0 = *(const bf16x8*)(rp_ + 3072 + 64 * dir + 8 * g4); lw1 = *(const bf16x8*)(rp_ + 3072 + 64 * dir + 32 + 8 * g4); \
            la0 = *(const bf16x8*)(rp_ + 3200 + 64 * dir + 8 * g4); la1 = *(const bf16x8*)(rp_ + 3200 + 64 * dir + 32 + 8 * g4); } while (0)
        f32x4 P0, P1, P2, P3, P4, P5; float Pssq, Pcp;
        f32x4 q_dec, q_av, q_cin, q_cex, q_rc, q_kf, q_rf, q_vf; float q_ri;
#define SC_PREP_A() do { f32x4 z_ = (f32x4){0.f, 0.f, 0.f, 0.f}, za_ = (f32x4){0.f, 0.f, 0.f, 0.f}; \
            z_ = __builtin_amdgcn_mfma_f32_16x16x32_bf16(ww0, lw0, z_, 0, 0, 0); z_ = __builtin_amdgcn_mfma_f32_16x16x32_bf16(ww1, lw1, z_, 0, 0, 0); \
            za_ = __builtin_amdgcn_mfma_f32_16x16x32_bf16(wa0, la0, za_, 0, 0, 0); za_ = __builtin_amdgcn_mfma_f32_16x16x32_bf16(wa1, la1, za_, 0, 0, 0); \
            q_kf = (f32x4){bf_lo(ld_k.x), bf_hi(ld_k.x), bf_lo(ld_k.y), bf_hi(ld_k.y)}; \
            q_rf = (f32x4){bf_lo(ld_r.x), bf_hi(ld_r.x), bf_lo(ld_r.y), bf_hi(ld_r.y)}; \
            q_vf = (f32x4){bf_lo(ld_v.x), bf_hi(ld_v.x), bf_lo(ld_v.y), bf_hi(ld_v.y)}; q_ri = ld_ri; \
            _Pragma("unroll") for (int jj = 0; jj < 4; ++jj) { q_dec[jj] = __expf(-0.60653066f * sigmoidf_(w0v[jj] + z_[jj])); q_av[jj] = sigmoidf_(a0v[jj] + za_[jj]); } } while (0)
#define SC_PREP_B() do { _Pragma("unroll") for (int jj = 0; jj < 4; ++jj) { float c_ = q_dec[jj]; \
                c_ *= dpp_row_shr_or1<1>(c_); c_ *= dpp_row_shr_or1<2>(c_); c_ *= dpp_row_shr_or1<4>(c_); c_ *= dpp_row_shr_or1<8>(c_); \
                q_cin[jj] = c_; q_cex[jj] = dpp_row_shr_or1<1>(c_); q_rc[jj] = __builtin_amdgcn_rcpf(c_); } } while (0)
#define SC_PREP_C() do { const f32x4 kkp_ = q_kf * kkv, kd_ = q_kf * ((q_av - 1.0f) * kav + 1.0f), bq_ = kkp_ * q_av; \
            const f32x4 rk3_ = q_rf * kd_ * rkv; float cp_ = (rk3_[0] + rk3_[1]) + (rk3_[2] + rk3_[3]); \
            cp_ += __shfl_xor(cp_, 16); cp_ += __shfl_xor(cp_, 32); \
            P0 = q_cin; P1 = kkp_ * q_cex * (-q_ri); P2 = bq_ * q_rc; P3 = kd_ * q_rc; P4 = q_rf * q_cin; P5 = q_vf; Pssq = 0.f; Pcp = cp_; } while (0)
#define SC_PREP() do { SC_PREP_A(); SC_PREP_B(); SC_PREP_C(); } while (0)
#define SC_PREP_STORE(pp) do { LAS float* bp_ = (LAS float*)(gl + (pp) * SC_BUF) + pn * SC_ST + dbase; \
            *(LAS f32x4*)(bp_) = P0; *(LAS f32x4*)(bp_ + 64) = P1; *(LAS f32x4*)(bp_ + 128) = P2; *(LAS f32x4*)(bp_ + 192) = P3; *(LAS f32x4*)(bp_ + 256) = P4; *(LAS f32x4*)(bp_ + 320) = P5; \
            if (g4 == 0) { part[((pp) * 2 + 1) * 64 + pn * 4 + w] = Pcp; } } while (0)
#define SC_FLUSH(cc, hh) do { float* yb_ = Y + (size_t)base_row * D + h * 64 + 16 * w; \
            _Pragma("unroll") for (int k2 = 0; k2 < 2; ++k2) { const int idx = lane + 64 * k2, n_ = idx >> 4, rr = idx & 15; const int sidx = 16 * (cc) + 8 * (hh) + n_; const int t_ = dir == 0 ? sidx : T - 1 - sidx; \
                const int yo_ = n_ * 128 + (rr & 1) * 64 + (rr >> 1) * 8; const f32x4 pa_ = *(const LAS f32x4*)(ybuf + yo_), pb_ = *(const LAS f32x4*)(ybuf + yo_ + 4); \
                atomicAdd(yb_ + (size_t)t_ * D + rr, (((pa_[0] + pa_[1]) + (pa_[2] + pa_[3])) + ((pb_[0] + pb_[1]) + (pb_[2] + pb_[3]))) * yscale); } } while (0)
        par ^= 1;
        SC_PREFETCH(0); SC_PREP(); SC_PREP_STORE(par);
        if (cpi > 1) SC_PREFETCH(1);
        SC_BAR();
        for (int cidx = 0; cidx < cpi; ++cidx) {
            const LAS float* buf = (const LAS float*)(gl + par * SC_BUF);
            if (lane < 16) {
                if (w == 0) { const f32x4 c4 = *(const LAS f32x4*)(part + (par * 2 + 1) * 64 + lane * 4); const int s0 = 16 * cidx + lane; const int t0 = dir == 0 ? s0 : T - 1 - s0;
                    CS[(size_t)(base_row + t0) * 32 + h * 2 + dir] = (c4[0] + c4[1]) + (c4[2] + c4[3]); } }
            asm volatile("s_waitcnt lgkmcnt(0)" ::: "memory");
            const bool more = cidx + 1 < cpi;
            f32x4 L[2][8]; f32x2 vvb[2];
#define SC_LOAD(nn, sl) do { const LAS float* vb_ = buf + (nn) * SC_ST + 8 * oc; _Pragma("unroll") for (int e2 = 0; e2 < 2; ++e2) { \
                L[sl][e2] = *(const LAS f32x4*)(vb_ + 64 + 4 * e2); L[sl][2 + e2] = *(const LAS f32x4*)(vb_ + 128 + 4 * e2); \
                L[sl][4 + e2] = *(const LAS f32x4*)(vb_ + 192 + 4 * e2); L[sl][6 + e2] = *(const LAS f32x4*)(vb_ + 256 + 4 * e2); } \
                vvb[sl] = *(const LAS f32x2*)(buf + (nn) * SC_ST + 320 + vrow); } while (0)
            SC_LOAD(0, 0);
#pragma unroll
            for (int n = 0; n < 16; ++n) {
                const int sl = n & 1;
                if (n < 15) SC_LOAD(n + 1, sl ^ 1);
                f32x2 kk2[4], b2[4], k2[4], r2[4];
#pragma unroll
                for (int e2 = 0; e2 < 2; ++e2) { const f32x4 c = L[sl][e2], d = L[sl][2 + e2], e = L[sl][4 + e2], f = L[sl][6 + e2];
                    kk2[2 * e2] = (f32x2){c[0], c[1]}; kk2[2 * e2 + 1] = (f32x2){c[2], c[3]}; b2[2 * e2] = (f32x2){d[0], d[1]}; b2[2 * e2 + 1] = (f32x2){d[2], d[3]};
                    k2[2 * e2] = (f32x2){e[0], e[1]}; k2[2 * e2 + 1] = (f32x2){e[2], e[3]}; r2[2 * e2] = (f32x2){f[0], f[1]}; r2[2 * e2 + 1] = (f32x2){f[2], f[3]}; }
                const f32x2 vv = vvb[sl];
                f32x2 d0 = S0[0] * kk2[0], d1 = S1[0] * kk2[0];
#pragma unroll
                for (int e = 1; e < 4; ++e) { d0 += S0[e] * kk2[e]; d1 += S1[e] * kk2[e]; }
                const float sa0 = oct_sum(d0.x + d0.y), sa1 = oct_sum(d1.x + d1.y);
                const f32x2 sa0v = (f32x2){sa0, sa0}, sa1v = (f32x2){sa1, sa1}, v0v = (f32x2){vv.x, vv.x}, v1v = (f32x2){vv.y, vv.y};
                f32x2 y0 = (f32x2){0.f, 0.f}, y1 = (f32x2){0.f, 0.f};
#pragma unroll
                for (int e = 0; e < 4; ++e) {
                    S0[e] = S0[e] + sa0v * b2[e] + v0v * k2[e]; S1[e] = S1[e] + sa1v * b2[e] + v1v * k2[e];
                    y0 += S0[e] * r2[e]; y1 += S1[e] * r2[e]; }
                { LAS float* yp_ = ybuf + (n & 7) * 128 + pr * 8 + oc; yp_[0] = y0.x + y0.y; yp_[64] = y1.x + y1.y; }
                if (n == 7) SC_FLUSH(cidx, 0);
                if (n == 15) SC_FLUSH(cidx, 1);
                if (n == 1) SC_PREP_A();
                if (n == 3) { const int c2 = cidx + 2 < cpi ? cidx + 2 : cpi - 1; SC_PREFETCH(c2); }
                if (n == 6) SC_PREP_B();
                if (n == 10) SC_PREP_C();
            }
#undef SC_LOAD
            {
                const f32x4 ca = *(const LAS f32x4*)(buf + 15 * SC_ST + 8 * oc), cb = *(const LAS f32x4*)(buf + 15 * SC_ST + 8 * oc + 4);
                const f32x2 ce[4] = {(f32x2){ca[0], ca[1]}, (f32x2){ca[2], ca[3]}, (f32x2){cb[0], cb[1]}, (f32x2){cb[2], cb[3]}};
#pragma unroll
                for (int e = 0; e < 4; ++e) { S0[e] = S0[e] * ce[e]; S1[e] = S1[e] * ce[e]; }
            }
            par ^= 1;
            if (more) SC_PREP_STORE(par);
            SC_BAR();
        }
        par ^= 1;
        if (grp == 1) { float* op = F.out + O_STATE + ((size_t)(((b * 2 + i) * 2 + dir) * 16 + h)) * 4096 + vrow * 64 + 8 * oc;
#pragma unroll
            for (int e2 = 0; e2 < 2; ++e2) { *(f32x4*)(op + 4 * e2) = (f32x4){S0[2 * e2].x, S0[2 * e2].y, S0[2 * e2 + 1].x, S0[2 * e2 + 1].y};
                *(f32x4*)(op + 64 + 4 * e2) = (f32x4){S1[2 * e2].x, S1[2 * e2].y, S1[2 * e2 + 1].x, S1[2 * e2 + 1].y}; } }
#undef SC_PREFETCH
#undef SC_PREP
#undef SC_PREP_A
#undef SC_PREP_B
#undef SC_PREP_C
#undef SC_PREP_STORE
#undef SC_FLUSH
    }
    for (int k = nb_mine; k < nb_oth; ++k) SC_BAR();
#undef SC_BAR
    __syncthreads();
}

__device__ __forceinline__ void phase_combine(const Frame& F, int l) {
    const int i = l >> 1;
    bf16_t* RK = (bf16_t*)(F.ws + WS_ACT + A_RKVL);
    const float* Y = (const float*)(F.ws + WS_ACT + A_H2);
    const float* CS = (const float*)(F.ws + WS_CS);
    const bf16_t* G = (const bf16_t*)(F.ws + WS_ACT + A_G);
    const int gw = F.bid * NWAVES + F.wave, NGW = F.G * NWAVES, lane = F.lane;
    const int hh = lane >> 2, col = hh * 64 + 16 * (lane & 3);
    f32x4 lw[4], lb[4];
#pragma unroll
    for (int e4 = 0; e4 < 4; ++e4) { lw[e4] = *(const f32x4*)(IN(F, 26) + (size_t)i * D + col + 4 * e4); lb[e4] = *(const f32x4*)(IN(F, 27) + (size_t)i * D + col + 4 * e4); }
    for (int row = gw; row < MTOK; row += NGW) {
        f32x4 y[4]; float s = 0.f;
#pragma unroll
        for (int e4 = 0; e4 < 4; ++e4) { y[e4] = *(const f32x4*)(Y + (size_t)row * D + col + 4 * e4); s += (y[e4][0] + y[e4][1]) + (y[e4][2] + y[e4][3]); }
        const float mean = quad_sum(s) * (1.0f / 64.0f); float q2 = 0.f;
#pragma unroll
        for (int e4 = 0; e4 < 4; ++e4) { y[e4] = y[e4] - mean; q2 += (y[e4][0] * y[e4][0] + y[e4][1] * y[e4][1]) + (y[e4][2] * y[e4][2] + y[e4][3] * y[e4][3]); }
        const float rstd = rsqrtf(quad_sum(q2) * (1.0f / 64.0f) + 64e-5f);
        const float cs = CS[(size_t)row * 32 + hh * 2] + CS[(size_t)row * 32 + hh * 2 + 1];
        const u32x4 va = *(const u32x4*)(RK + (size_t)row * LDR + 2048 + col), vb = *(const u32x4*)(RK + (size_t)row * LDR + 2048 + col + 8);
        const u32x4 ga = *(const u32x4*)(G + (size_t)row * D + col), gb = *(const u32x4*)(G + (size_t)row * D + col + 8);
        const unsigned vv[8] = {va.x, va.y, va.z, va.w, vb.x, vb.y, vb.z, vb.w}; const unsigned gg[8] = {ga.x, ga.y, ga.z, ga.w, gb.x, gb.y, gb.z, gb.w};
        unsigned ow[8];
#pragma unroll
        for (int p = 0; p < 8; ++p) { const int e4 = p >> 1, e = (p & 1) * 2;
            const float o0 = (y[e4][e] * rstd * lw[e4][e] + lb[e4][e] + cs * bf_lo(vv[p])) * bf_lo(gg[p]);
            const float o1 = (y[e4][e + 1] * rstd * lw[e4][e + 1] + lb[e4][e + 1] + cs * bf_hi(vv[p])) * bf_hi(gg[p]);
            ow[p] = cvt_pk_bf16(o0, o1); }
        *(u32x4*)(RK + (size_t)row * LDR + col) = (u32x4){ow[0], ow[1], ow[2], ow[3]}; *(u32x4*)(RK + (size_t)row * LDR + col + 8) = (u32x4){ow[4], ow[5], ow[6], ow[7]};
    }
}

template <bool LAT>
__device__ __forceinline__ void attn_task(const Frame& F, int id, int li, LAS unsigned char* lctx) {
    const bf16_t* QK = (const bf16_t*)(F.ws + WS_ACT + A_QK);
    const bf16_t* VT = (const bf16_t*)(F.ws + WS_ACT + A_VT);
    const bf16_t* CKB = (const bf16_t*)(F.ws + WS_ACT + A_CKB);
    const bf16_t* CVT = (const bf16_t*)(F.ws + WS_ACT + A_CVT);
    bf16_t* O = (bf16_t*)(F.ws + WS_ACT + A_HN);
    const int lane = F.lane, n = lane & 15, g = lane >> 4;
    int b, h, qrow0, seq0, r = 0, cb = 0, rs = 0, band = 0;
    if (LAT) { cb = id & 3; r = (id >> 2) & 63; h = (id >> 8) & 15; b = id >> 12; seq0 = MCTX + b * 4096; qrow0 = seq0 + r * 64 + cb * 16;
        rs = r - 4; rs = rs < 0 ? 0 : (rs > 56 ? 56 : rs); band = cb == 0 ? 0 : (cb == 1 ? 8 : (cb == 2 ? 24 : 32)); }
    else { const int qb = id & 15; h = (id >> 4) & 15; b = id >> 8; seq0 = b * 256; qrow0 = seq0 + qb * 16; }
    const bf16_t* Qp = QK + (size_t)(qrow0 + n) * 2048 + h * 64 + 8 * g;
    const bf16x8 q0 = *(const bf16x8*)Qp, q1 = *(const bf16x8*)(Qp + 32);
    const float* rpb = IN(F, 32) + ((size_t)(li * 16 + h)) * 15 * 31;
    const int qcol = cb * 16 + n; int wst = qcol - 8; wst = wst < 0 ? 0 : (wst > 48 ? 48 : wst);
    float m_run = 0.f, l_run = 0.f;
    f32x4 o[4];
#pragma unroll
    for (int dt = 0; dt < 4; ++dt) o[dt] = (f32x4){0.f, 0.f, 0.f, 0.f};
    constexpr int NSEG = LAT ? 2 : 1;
#pragma unroll
    for (int seg = 0; seg < NSEG; ++seg) {
        const bool win = LAT && seg == 0;
        const char* kub; unsigned kvo; size_t kst;
        const int nk = 8 * (n >> 2) + (n & 3);
        if (win) { kub = (const char*)(QK + (size_t)(seq0 + rs * 64 + band) * 2048 + 1024 + h * 64); kvo = (unsigned)(nk * 2048 + 8 * g) * 2u; kst = 0; }
        else if (LAT) { kub = (const char*)(CKB + (size_t)(b * 16 + h) * 256 * 64); kvo = (unsigned)(nk * 64 + 8 * g) * 2u; kst = 64 * 2; }
        else { kub = (const char*)(QK + (size_t)seq0 * 2048 + 1024 + h * 64); kvo = (unsigned)(nk * 2048 + 8 * g) * 2u; kst = (size_t)2048 * 2; }
        f32x4 s[16];
        bf16x8 kb[2][2];
#define AT_LOADK(gi, sl) do { _Pragma("unroll") for (int t = 0; t < 1; ++t) { const int ti = (gi) + t; \
            const char* kp = (win ? kub + ((size_t)(ti >> 1) * 64 + 4 * (ti & 1)) * 4096 : kub + (size_t)(32 * (ti >> 1) + 4 * (ti & 1)) * kst) + kvo; \
            kb[sl][2 * t] = *(const bf16x8*)kp; kb[sl][2 * t + 1] = *(const bf16x8*)(kp + 64); } } while (0)
        const bool cl = LAT && seg == 1;
        const LAS unsigned char* klds = lctx + (unsigned)(nk * 144 + 16 * g);
#define AT_LOADK_L(gi, sl) do { const int ti = (gi); const LAS unsigned char* kp = klds + (32 * (ti >> 1) + 4 * (ti & 1)) * 144; \
            kb[sl][0] = *(const LAS bf16x8*)kp; kb[sl][1] = *(const LAS bf16x8*)(kp + 64); } while (0)
        if (cl) AT_LOADK_L(0, 0); else AT_LOADK(0, 0);
        float mx = -3.0e38f;
#pragma unroll
        for (int gi = 0; gi < 16; ++gi) {
            if (gi < 15) { if (cl) AT_LOADK_L(gi + 1, (gi + 1) & 1); else AT_LOADK(gi + 1, (gi + 1) & 1); }
            __builtin_amdgcn_sched_barrier(0);
#pragma unroll
            for (int t = 0; t < 1; ++t) { const int ti = gi + t;
                f32x4 a = (f32x4){0.f, 0.f, 0.f, 0.f};
                a = __builtin_amdgcn_mfma_f32_16x16x32_bf16(kb[gi & 1][2 * t], q0, a, 0, 0, 0); a = __builtin_amdgcn_mfma_f32_16x16x32_bf16(kb[gi & 1][2 * t + 1], q1, a, 0, 0, 0);
                if (win) { const int j = ti >> 1, half = ti & 1; const float* rp = rpb + (rs + j - r + 7) * 31;
#pragma unroll
                    for (int jj = 0; jj < 4; ++jj) { const int kc = band + 8 * g + 4 * half + jj; const bool valid = kc >= wst && kc < wst + 16;
                        int co = kc - qcol + 15; co = co < 0 ? 0 : (co > 30 ? 30 : co);
                        a[jj] = valid ? a[jj] * 0.125f + rp[co] : -1e30f; }
                } else a = a * 0.125f;
                mx = fmaxf(mx, fmaxf(fmaxf(a[0], a[1]), fmaxf(a[2], a[3])));
                s[ti] = a; }
            __builtin_amdgcn_sched_barrier(0);
        }
#undef AT_LOADK
#undef AT_LOADK_L
        mx = fmaxf(mx, __shfl_xor(mx, 16)); mx = fmaxf(mx, __shfl_xor(mx, 32));
        if (seg > 0) { const float mn = fmaxf(m_run, mx), ea = __expf(m_run - mn); l_run *= ea; mx = mn;
#pragma unroll
            for (int dt = 0; dt < 4; ++dt) o[dt] = o[dt] * ea; }
        m_run = mx;
        float sum = 0.f;
#pragma unroll
        for (int ti = 0; ti < 16; ++ti) {
#pragma unroll
            for (int jj = 0; jj < 4; ++jj) { const float p = __expf(s[ti][jj] - mx); s[ti][jj] = p; sum += p; } }
        sum += __shfl_xor(sum, 16); sum += __shfl_xor(sum, 32);
        l_run += sum;
        const char* vub; unsigned vvo; size_t vsd, vsk;
        if (win) { vub = (const char*)(VT + (size_t)(h * 64) * MTOK + seq0 + rs * 64 + band); vvo = (unsigned)(n * MTOK + 8 * g) * 2u; vsd = (size_t)16 * MTOK * 2; vsk = 64 * 2; }
        else if (LAT) { vub = (const char*)(CVT + (size_t)(b * 16 + h) * 64 * 256); vvo = (unsigned)(n * 256 + 8 * g) * 2u; vsd = 16 * 256 * 2; vsk = 32 * 2; }
        else { vub = (const char*)(VT + (size_t)(h * 64) * MTOK + seq0); vvo = (unsigned)(n * MTOK + 8 * g) * 2u; vsd = (size_t)16 * MTOK * 2; vsk = 32 * 2; }
        bf16x8 vb[2][4];
#define AT_LOADV(ks_, sl) do { _Pragma("unroll") for (int dt = 0; dt < 4; ++dt) { \
            const char* vp = vub + (size_t)dt * vsd + (size_t)(ks_) * vsk + vvo; vb[sl][dt] = *(const bf16x8*)vp; } } while (0)
        const LAS unsigned char* vlds = lctx + 36864 + (unsigned)(n * 528 + 16 * g);
#define AT_LOADV_L(ks_, sl) do { _Pragma("unroll") for (int dt = 0; dt < 4; ++dt) vb[sl][dt] = *(const LAS bf16x8*)(vlds + dt * (16 * 528) + (ks_) * 64); } while (0)
        if (cl) AT_LOADV_L(0, 0); else AT_LOADV(0, 0);
#pragma unroll
        for (int ks = 0; ks < 8; ++ks) {
            if (ks < 7) { if (cl) AT_LOADV_L(ks + 1, (ks + 1) & 1); else AT_LOADV(ks + 1, (ks + 1) & 1); }
            __builtin_amdgcn_sched_barrier(0);
            { const unsigned p0 = cvt_pk_bf16(s[2 * ks][0], s[2 * ks][1]), p1 = cvt_pk_bf16(s[2 * ks][2], s[2 * ks][3]), p2 = cvt_pk_bf16(s[2 * ks + 1][0], s[2 * ks + 1][1]), p3 = cvt_pk_bf16(s[2 * ks + 1][2], s[2 * ks + 1][3]);
                const bf16x8 pf = __builtin_bit_cast(bf16x8, (u32x4){p0, p1, p2, p3});
#pragma unroll
                for (int dt = 0; dt < 4; ++dt) { const bf16x8 vf = vb[ks & 1][dt];
                    o[dt] = __builtin_amdgcn_mfma_f32_16x16x32_bf16(vf, pf, o[dt], 0, 0, 0); } }
            __builtin_amdgcn_sched_barrier(0);
        }
#undef AT_LOADV
#undef AT_LOADV_L
    }
    const float inv = 1.0f / l_run;
    bf16_t* op = O + (size_t)(qrow0 + n) * D + h * 64 + 4 * g;
#pragma unroll
    for (int dt = 0; dt < 4; ++dt) { const f32x4 v = o[dt] * inv; u32x2 w; w.x = cvt_pk_bf16(v[0], v[1]); w.y = cvt_pk_bf16(v[2], v[3]); *(u32x2*)(op + 16 * dt) = w; }
}
constexpr int AL_CK = 0, AL_CV = 36864, AL_WIN = 70656, AL_VST = 1168;
__device__ __forceinline__ int al_swz(int key) { return ((key >> 1) & 1) | (((key >> 3) & 3) << 1); }
__device__ __forceinline__ void attn_lat_block(const Frame& F, int bh, int half, int li) {
    const bf16_t* QK = (const bf16_t*)(F.ws + WS_ACT + A_QK);
    const bf16_t* VT = (const bf16_t*)(F.ws + WS_ACT + A_VT);
    const bf16_t* CKB = (const bf16_t*)(F.ws + WS_ACT + A_CKB);
    const bf16_t* CVT = (const bf16_t*)(F.ws + WS_ACT + A_CVT);
    bf16_t* O = (bf16_t*)(F.ws + WS_ACT + A_HN);
    const int lane = F.lane, n = lane & 15, g = lane >> 4, tid = F.wave * 64 + lane;
    const int b = bh >> 4, h = bh & 15, seq0 = MCTX + b * 4096;
    LAS unsigned char* L = F.lds;
    __syncthreads();
    for (int c = tid; c < 2048; c += NTHR) { const int key = c >> 3, ch = c & 7; *(LAS u32x4*)(L + AL_CK + key * 144 + ch * 16) = *(const u32x4*)(CKB + ((size_t)bh * 256 + key) * 64 + ch * 8); }
    for (int c = tid; c < 2048; c += NTHR) { const int d = c >> 5, ch = c & 31; *(LAS u32x4*)(L + AL_CV + d * 528 + ch * 16) = *(const u32x4*)(CVT + ((size_t)bh * 64 + d) * 256 + ch * 8); }
    const float* rpb = IN(F, 32) + ((size_t)(li * 16 + h)) * 15 * 31;
    const int cb = F.wave & 3, band = cb == 0 ? 0 : (cb == 1 ? 8 : (cb == 2 ? 24 : 32));
    const int qcol = cb * 16 + n; int wst = qcol - 8; wst = wst < 0 ? 0 : (wst > 48 ? 48 : wst);
    const int nk = 8 * (n >> 2) + (n & 3);
    for (int jp = 0; jp < 16; ++jp) {
        const int rA = 32 * half + 2 * jp; int rsA = rA - 4; rsA = rsA < 0 ? 0 : (rsA > 56 ? 56 : rsA);
        const int nrows = (64 - rsA) < 9 ? (64 - rsA) : 9;
        const int r = rA + (F.wave >> 2); int rs = r - 4; rs = rs < 0 ? 0 : (rs > 56 ? 56 : rs);
        const int jl0 = rs - rsA;
        __syncthreads();
        { u32x4 tk[9]; const int key = (tid >> 3) & 63, ch = tid & 7;
#pragma unroll
            for (int j = 0; j < 9; ++j) if (j < nrows) tk[j] = *(const u32x4*)(QK + (size_t)(seq0 + (rsA + j) * 64 + key) * 2048 + 1024 + h * 64 + ch * 8);
#pragma unroll
            for (int j = 0; j < 9; ++j) if (j < nrows) *(LAS u32x4*)(L + AL_WIN + (j * 64 + key) * 128 + ((ch ^ al_swz(key)) * 16)) = tk[j]; }
        const bf16_t* Qp = QK + (size_t)(seq0 + r * 64 + cb * 16 + n) * 2048 + h * 64 + 8 * g;
        const bf16x8 q0 = *(const bf16x8*)Qp, q1 = *(const bf16x8*)(Qp + 32);
        __syncthreads();
        f32x4 s[32];
        float mx = -3.0e38f;
#pragma unroll
        for (int ti = 0; ti < 16; ++ti) { const int j = ti >> 1, hf = ti & 1;
            const int kc = band + nk + 4 * hf, sw = al_swz(kc);
            const LAS unsigned char* kp = L + AL_WIN + ((jl0 + j) * 64 + kc) * 128;
            const bf16x8 k0 = *(const LAS bf16x8*)(kp + ((g ^ sw) * 16)), k1 = *(const LAS bf16x8*)(kp + (((4 + g) ^ sw) * 16));
            f32x4 a = (f32x4){0.f, 0.f, 0.f, 0.f};
            a = __builtin_amdgcn_mfma_f32_16x16x32_bf16(k0, q0, a, 0, 0, 0); a = __builtin_amdgcn_mfma_f32_16x16x32_bf16(k1, q1, a, 0, 0, 0);
            const float* rp = rpb + (rs + j - r + 7) * 31;
#pragma unroll
            for (int jj = 0; jj < 4; ++jj) { const int kcc = band + 8 * g + 4 * hf + jj; const bool valid = kcc >= wst && kcc < wst + 16;
                int co = kcc - qcol + 15; co = co < 0 ? 0 : (co > 30 ? 30 : co);
                a[jj] = valid ? a[jj] * 0.125f + rp[co] : -1e30f; }
            mx = fmaxf(mx, fmaxf(fmaxf(a[0], a[1]), fmaxf(a[2], a[3])));
            s[ti] = a; }
#pragma unroll
        for (int ti = 0; ti < 16; ++ti) { const int key = 32 * (ti >> 1) + 4 * (ti & 1) + nk;
            const LAS unsigned char* kp = L + AL_CK + key * 144 + 16 * g;
            const bf16x8 k0 = *(const LAS bf16x8*)kp, k1 = *(const LAS bf16x8*)(kp + 64);
            f32x4 a = (f32x4){0.f, 0.f, 0.f, 0.f};
            a = __builtin_amdgcn_mfma_f32_16x16x32_bf16(k0, q0, a, 0, 0, 0); a = __builtin_amdgcn_mfma_f32_16x16x32_bf16(k1, q1, a, 0, 0, 0);
            a = a * 0.125f; mx = fmaxf(mx, fmaxf(fmaxf(a[0], a[1]), fmaxf(a[2], a[3])));
            s[16 + ti] = a; }
        mx = fmaxf(mx, __shfl_xor(mx, 16)); mx = fmaxf(mx, __shfl_xor(mx, 32));
        float sum = 0.f;
#pragma unroll
        for (int ti = 0; ti < 32; ++ti) {
#pragma unroll
            for (int jj = 0; jj < 4; ++jj) { const float p = __expf(s[ti][jj] - mx); s[ti][jj] = p; sum += p; } }
        sum += __shfl_xor(sum, 16); sum += __shfl_xor(sum, 32);
        __syncthreads();
        { const int d = tid >> 3, ch = tid & 7;
#pragma unroll
          for (int hb = 0; hb < 2; ++hb) { u32x4 tv[5];
#pragma unroll
            for (int jq = 0; jq < 5; ++jq) { const int j = 5 * hb + jq; if (j < nrows) tv[jq] = *(const u32x4*)(VT + (size_t)(h * 64 + d) * MTOK + seq0 + (rsA + j) * 64 + ch * 8); }
#pragma unroll
            for (int jq = 0; jq < 5; ++jq) { const int j = 5 * hb + jq; if (j < nrows) *(LAS u32x4*)(L + AL_WIN + d * AL_VST + (j * 64 + ch * 8) * 2) = tv[jq]; } } }
        __syncthreads();
        f32x4 o[4];
#pragma unroll
        for (int dt = 0; dt < 4; ++dt) o[dt] = (f32x4){0.f, 0.f, 0.f, 0.f};
#pragma unroll
        for (int ks = 0; ks < 16; ++ks) {
            const unsigned p0 = cvt_pk_bf16(s[2 * ks][0], s[2 * ks][1]), p1 = cvt_pk_bf16(s[2 * ks][2], s[2 * ks][3]), p2 = cvt_pk_bf16(s[2 * ks + 1][0], s[2 * ks + 1][1]), p3 = cvt_pk_bf16(s[2 * ks + 1][2], s[2 * ks + 1][3]);
            const bf16x8 pf = __builtin_bit_cast(bf16x8, (u32x4){p0, p1, p2, p3});
#pragma unroll
            for (int dt = 0; dt < 4; ++dt) {
                const LAS unsigned char* vp = ks < 8 ? L + AL_WIN + (16 * dt + n) * AL_VST + ((jl0 + ks) * 64 + band + 8 * g) * 2 : L + AL_CV + (16 * dt + n) * 528 + (32 * (ks - 8) + 8 * g) * 2;
                const bf16x8 vf = *(const LAS bf16x8*)vp;
                o[dt] = __builtin_amdgcn_mfma_f32_16x16x32_bf16(vf, pf, o[dt], 0, 0, 0); } }
        const float inv = 1.0f / sum;
        bf16_t* op = O + (size_t)(seq0 + r * 64 + cb * 16 + n) * D + h * 64 + 4 * g;
#pragma unroll
        for (int dt = 0; dt < 4; ++dt) { const f32x4 v = o[dt] * inv; u32x2 w; w.x = cvt_pk_bf16(v[0], v[1]); w.y = cvt_pk_bf16(v[2], v[3]); *(u32x2*)(op + 16 * dt) = w; }
    }
}
__device__ __forceinline__ void phase_attn(const Frame& F, int l) {
    const int li = l >> 1; const int gw = F.bid * NWAVES + F.wave, NGW = F.G * NWAVES;
    for (int bt = F.bid; bt < 256; bt += F.G) attn_lat_block(F, bt >> 1, bt & 1, li);
    __syncthreads();
    for (int id = gw; id < 4096; id += NGW) attn_task<false>(F, id, li, F.lds);
}

#define XB_TMO      128
#define XB_XCNT(j)  (256  + 64 * (j))
#define XB_XSUB(j)  (1280 + 64 * (j))
#define XB_XGEN(j)  (2304 + 64 * (j))
#define XB_TOP      3328
#define XB_TOPGEN   3392
#define XCD_BAR_WORDS 3456
#define XB_SPIN_CAP (1u << 18)
constexpr size_t WS_BAR = 983040;
constexpr int BARST_OFF = 146944 + 384;
__device__ __forceinline__ unsigned xb_ld(unsigned* p)              { return __hip_atomic_load(p, __ATOMIC_RELAXED, __HIP_MEMORY_SCOPE_AGENT); }
__device__ __forceinline__ unsigned xb_add(unsigned* p, unsigned v) { return __hip_atomic_fetch_add(p, v, __ATOMIC_RELAXED, __HIP_MEMORY_SCOPE_AGENT); }
__device__ __forceinline__ unsigned xb_xcc_id() { return (unsigned)__builtin_amdgcn_s_getreg((3 << 11) | 20) & 0xFu; }
#define XB_SPIN(cond, bar) do { unsigned _sp = 0; while (cond) { __builtin_amdgcn_s_sleep(1); \
    if ((++_sp & 255u) == 0u) { if (xb_ld(&(bar)[XB_TMO])) break; if (_sp > XB_SPIN_CAP) { atomicAdd(&(bar)[XB_TMO], 1u); break; } } } } while (0)
__device__ __forceinline__ void xcd_barrier_complete(unsigned* bar, unsigned x, unsigned& nloc, unsigned& nx) {
    const unsigned G = gridDim.x * gridDim.y * gridDim.z;
    unsigned sum, cnt, mine, sp = 0u;
    for (;;) {
        sum = 0u; cnt = 0u; mine = 0u;
#pragma unroll
        for (unsigned j = 0; j < 16; ++j) { const unsigned c = xb_ld(&bar[XB_XCNT(j)]); sum += c; cnt += (c > 0u) ? 1u : 0u; mine = (j == x) ? c : mine; }
        if (sum == G) break;
        __builtin_amdgcn_s_sleep(1);
        if ((++sp & 255u) == 0u) { if (xb_ld(&bar[XB_TMO])) break; if (sp > XB_SPIN_CAP) { atomicAdd(&bar[XB_TMO], 1u); break; } }
    }
    nloc = mine > 0u ? mine : 1u; nx = cnt > 0u ? cnt : 1u;
}
__device__ __forceinline__ void xcd_barrier(unsigned* bar, unsigned x, volatile LAS unsigned* st) {
    asm volatile("s_waitcnt vmcnt(0)" ::: "memory");
    __syncthreads();
    if (threadIdx.x == 0) {
        __builtin_amdgcn_s_waitcnt(0);
        unsigned nloc = st[0], nx = st[1];
        if (nloc == 0u) { xcd_barrier_complete(bar, x, nloc, nx); st[0] = nloc; st[1] = nx; }
        const unsigned old = xb_add(&bar[XB_XSUB(x)], 1u);
        const unsigned gen = old / nloc;
        if (old + 1u == (gen + 1u) * nloc) {
            __builtin_amdgcn_fence(__ATOMIC_RELEASE, "agent");
            asm volatile("s_waitcnt vmcnt(0)" ::: "memory");
            const unsigned og = xb_add(&bar[XB_TOP], 1u);
            const unsigned tg = og / nx;
            if (og + 1u == (tg + 1u) * nx) xb_add(&bar[XB_TOPGEN], 1u);
            else XB_SPIN(xb_ld(&bar[XB_TOPGEN]) == tg, bar);
            __builtin_amdgcn_fence(__ATOMIC_ACQUIRE, "agent");
            xb_add(&bar[XB_XGEN(x)], 1u);
            asm volatile("s_waitcnt vmcnt(0)" ::: "memory");
        } else {
            XB_SPIN(xb_ld(&bar[XB_XGEN(x)]) == gen, bar);
            __builtin_amdgcn_fence(__ATOMIC_ACQUIRE, "agent");
            asm volatile("s_waitcnt vmcnt(0)" ::: "memory");
        }
    }
    __syncthreads();
}

#define LAUNDER_PTR(T, p) { unsigned long long ip_ = (unsigned long long)(p); unsigned lo_ = (unsigned)ip_, hi_ = (unsigned)(ip_ >> 32); asm volatile("" : "+v"(lo_), "+v"(hi_)); \
            lo_ = __builtin_amdgcn_readfirstlane(lo_); hi_ = __builtin_amdgcn_readfirstlane(hi_); p = (T)(__attribute__((address_space(1))) unsigned char*)(((unsigned long long)hi_ << 32) | lo_); }
#define MK_FRAME(F) Frame F; { int wv_ = wave_s; asm volatile("" : "+s"(wv_)); \
          int ln_; asm volatile("v_mbcnt_lo_u32_b32 %0, -1, 0\n\tv_mbcnt_hi_u32_b32 %0, -1, %0" : "=v"(ln_)); \
          int tid = wv_ * 64 + ln_, G = gridDim.x, bid = blockIdx.x; float* outp = args.out; unsigned char* wsp = args.ws; unsigned ldsb = 0; \
          asm volatile("" : "+v"(G), "+v"(bid), "+v"(ldsb)); \
          G = __builtin_amdgcn_readfirstlane(G); bid = __builtin_amdgcn_readfirstlane(bid); ldsb = __builtin_amdgcn_readfirstlane(ldsb); \
          LAUNDER_PTR(float*, outp) LAUNDER_PTR(unsigned char*, wsp) \
          F.lds = (LAS unsigned char*)lds_raw + ldsb; \
          F.tid = tid; F.lane = ln_; F.wave = wv_; F.G = G; F.bid = bid; F.cbid = bid; F.cG = G; F.rot = 0; F.out = outp; F.ws = wsp; }
constexpr int NPHASES = 37;
__global__ void __launch_bounds__(NTHR) mk_fwd(Args args) {
    extern __shared__ __attribute__((aligned(16))) unsigned char lds_raw[];
    cg::grid_group grid = cg::this_grid();
    if (threadIdx.x == 0) { LAS unsigned long long* tab = (LAS unsigned long long*)((LAS unsigned char*)lds_raw + TAB_OFF);
#pragma unroll
        for (int k = 0; k < 33; ++k) tab[k] = (unsigned long long)args.in[k];
        volatile LAS unsigned* st0 = (volatile LAS unsigned*)((LAS unsigned char*)lds_raw + BARST_OFF); st0[0] = 0u; st0[1] = 0u;
        (void)xb_add((unsigned*)(args.ws + WS_BAR) + XB_XCNT(xb_xcc_id()), 1u); }
    const unsigned my_xcc = xb_xcc_id();
    int nsync = 0;
    __syncthreads();
    bool need_sync = false;
    const int wave_s = __builtin_amdgcn_readfirstlane(threadIdx.x >> 6);
    for (int ph = args.lo; ph < args.hi; ++ph) {
        const int l = (ph - 1) / 9, slot = (ph - 1) % 9; const bool rw = (l & 1) == 0;
        if (ph > 0 && !rw && (slot == 3 || slot == 4)) continue;
        if (need_sync) { for (int rep = 0; rep < REP_SYNC; ++rep) { if (nsync == 0) grid.sync(); else xcd_barrier((unsigned*)(args.ws + WS_BAR), my_xcc, (volatile LAS unsigned*)((LAS unsigned char*)lds_raw + BARST_OFF)); ++nsync; } }
        need_sync = true;
        if (ph == 0) { MK_FRAME(F) for (int rep = 0; rep < REP_ELT; ++rep) { phase_p0(F); __syncthreads(); conv_rwkv(F, 0); } continue; }
        switch (slot) {
        case 0: { MK_FRAME(F) float* modv = (float*)(F.ws + WS_MODV) + (size_t)l * NCOND * 6144; pg8::StaticOrder S; (void)modv; (void)S;
                for (int rep = 0; rep < REP_ELT; ++rep) { conv_w2(F, l); if (rw) phase_pre_rwkv(F, l); else phase_norm(F, l, 0); } } break;
        case 1: { MK_FRAME(F) float* modv = (float*)(F.ws + WS_MODV) + (size_t)l * NCOND * 6144; pg8::StaticOrder S; (void)modv; (void)S;
                for (int rep = 0; rep < REP_GEMM; ++rep) {
                if (rw) { pg8::Gemm g{(const bf16_t*)(F.ws + WS_ACT + A_H2), 2048, (const bf16_t*)(F.ws + WS_WT + WT_CAT), 3584, 2048}; S.init(MTOK, 3584, F.G, F.bid, 2);
                          pg8::EpiRKVL E{(bf16_t*)(F.ws + WS_ACT + A_RKVL), IN(F, 23) + (size_t)(l >> 1) * D}; pg8::gemm_phase(F.lds, F.tid, g, S, E); }
                else { pg8::Gemm g{(const bf16_t*)(F.ws + WS_ACT + A_HN), D, (const bf16_t*)(F.ws + WS_WT + WT_QKV), 3072, D}; S.init(MTOK, 3072, F.G, F.bid);
                       pg8::EpiQKV E{(bf16_t*)(F.ws + WS_ACT + A_QK), (bf16_t*)(F.ws + WS_ACT + A_VT), IN(F, 30) + (l >> 1) * 64, IN(F, 31) + (l >> 1) * 64, F.out + O_CK, F.out + O_CV, l >> 1};
                       pg8::gemm_phase(F.lds, F.tid, g, S, E); } }
                } break;
        case 2: { MK_FRAME(F) float* modv = (float*)(F.ws + WS_MODV) + (size_t)l * NCOND * 6144; pg8::StaticOrder S; (void)modv; (void)S;
                if (rw) { for (int rep = 0; rep < REP_GEMM; ++rep) { int k256 = 128; asm volatile("" : "+s"(k256));
                          pg8::Gemm g{(const bf16_t*)(F.ws + WS_ACT + A_RKVL) + 3328, LDR, (const bf16_t*)(F.ws + WS_WT + WT_G2), 1024, k256}; S.init(MTOK, 1024, F.G, F.bid);
                          pg8::EpiBf16<0> E{(bf16_t*)(F.ws + WS_ACT + A_G), D}; pg8::gemm_phase(F.lds, F.tid, g, S, E); }
                          { const int extra = 576 % F.G; if (extra == 0 || F.bid >= extra) { if (extra != 0) { F.cbid = F.bid - extra; F.cG = F.G - extra; }
                              for (int rep = 0; rep < REP_ELT; ++rep) zero_bytes_c(F, F.ws + WS_ACT + A_H2, (size_t)MTOK * D * 4); } } }
                else { for (int rep = 0; rep < REP_ATTN; ++rep) phase_attn(F, l); }
                } break;
        case 3: { MK_FRAME(F) float* modv = (float*)(F.ws + WS_MODV) + (size_t)l * NCOND * 6144; pg8::StaticOrder S; (void)modv; (void)S;
                for (int rep = 0; rep < REP_SCAN; ++rep) phase_scan(F, l, rep == REP_SCAN - 1 ? 1.0f : 0.0f); } break;
        case 4: { MK_FRAME(F) float* modv = (float*)(F.ws + WS_MODV) + (size_t)l * NCOND * 6144; pg8::StaticOrder S; (void)modv; (void)S;
                for (int rep = 0; rep < REP_ELT; ++rep) phase_combine(F, l); } break;
        case 5: { MK_FRAME(F) float* modv = (float*)(F.ws + WS_MODV) + (size_t)l * NCOND * 6144; pg8::StaticOrder S; (void)modv; (void)S;
                for (int rep = 0; rep < REP_GEMM; ++rep) { pg8::Gemm g{(const bf16_t*)(F.ws + WS_ACT + (rw ? A_RKVL : A_HN)), rw ? LDR : D, (const bf16_t*)(F.ws + WS_WT + WT_WO), 1024, D}; S.init(MTOK, 1024, F.G, F.bid);
                  if (l == 0) { pg8::EpiRes<true> E{F.out, modv + 2 * 1024, rep == REP_GEMM - 1 ? 1.0f : 0.0f, F.lds + TAB_OFF}; pg8::gemm_phase(F.lds, F.tid, g, S, E); }
                  else { pg8::EpiRes<false> E{F.out, modv + 2 * 1024, rep == REP_GEMM - 1 ? 1.0f : 0.0f, F.lds + TAB_OFF}; pg8::gemm_phase(F.lds, F.tid, g, S, E); } } } break;
        case 6: { MK_FRAME(F) float* modv = (float*)(F.ws + WS_MODV) + (size_t)l * NCOND * 6144; pg8::StaticOrder S; (void)modv; (void)S;
                for (int rep = 0; rep < REP_ELT; ++rep) phase_norm(F, l, 1); } break;
        case 7: { MK_FRAME(F) float* modv = (float*)(F.ws + WS_MODV) + (size_t)l * NCOND * 6144; pg8::StaticOrder S; (void)modv; (void)S;
                for (int rep = 0; rep < REP_GEMM; ++rep) { pg8::Gemm g{(const bf16_t*)(F.ws + WS_ACT + A_HN), D, (const bf16_t*)(F.ws + WS_WT + WT_W1), FF, D}; S.init(MTOK, FF, F.G, F.bid);
                  pg8::EpiBf16<1> E{(bf16_t*)(F.ws + WS_ACT + A_U), FF}; pg8::gemm_phase(F.lds, F.tid, g, S, E); } } break;
        case 8: { MK_FRAME(F) float* modv = (float*)(F.ws + WS_MODV) + (size_t)l * NCOND * 6144; pg8::StaticOrder S; (void)modv; (void)S;
                for (int rep = 0; rep < REP_GEMM; ++rep) { pg8::Gemm g{(const bf16_t*)(F.ws + WS_ACT + A_U), FF, (const bf16_t*)(F.ws + WS_WT + WT_W2), 1024, FF}; S.init(MTOK, 1024, F.G, F.bid, 2);
                  pg8::EpiRes<false> E{F.out, modv + 5 * 1024, rep == REP_GEMM - 1 ? 1.0f : 0.0f, F.lds + TAB_OFF}; pg8::gemm_phase(F.lds, F.tid, g, S, E); }
                if (l < 3) {
                    const int extra = 576 % F.G; bool doit = true;
                    if (extra != 0) { if (F.bid < extra) doit = false; else { F.cbid = F.bid - extra; F.cG = F.G - extra; } }
                    if (doit) { if (((l + 1) & 1) == 0) conv_rwkv(F, l + 1); else conv_na(F, l + 1); } } } break;
        }
    }
}

extern "C" void kernel_launch(void* const* d_in, const int* in_sizes, int n_in, void* d_out, int out_size, void* d_ws, size_t ws_size, hipStream_t stream) {
    static int grid = 0;
    if (grid == 0) {
        if (n_in != 33 || ws_size < WS_END) { fprintf(stderr, "kernel_launch: need 33 inputs and %zu bytes of workspace; got %d, %zu\n", (size_t)WS_END, n_in, ws_size); grid = -1; return; }
        int dev = 0, cus = 0, per_cu = 0;
        hipGetDevice(&dev); hipDeviceGetAttribute(&cus, hipDeviceAttributeMultiprocessorCount, dev);
        hipFuncSetAttribute((const void*)mk_fwd, hipFuncAttributeMaxDynamicSharedMemorySize, LDS_BYTES);
        hipOccupancyMaxActiveBlocksPerMultiprocessor(&per_cu, (const void*)mk_fwd, NTHR, LDS_BYTES);
        (void)hipGetLastError();
        if (per_cu < 1) per_cu = 1;
        grid = cus;
        if (grid > 256) grid = 256;
    }
    if (grid < 0) return;
    (void)hipMemsetAsync((char*)d_ws + WS_BAR, 0, XCD_BAR_WORDS * 4, stream);
    Args a{};
    for (int i = 0; i < 33; ++i) a.in[i] = (const float*)d_in[i];
    a.out = (float*)d_out; a.ws = (unsigned char*)d_ws;
#if MK_N_LAUNCH_PER_PHASE
    for (int ph = 0; ph < NPHASES; ++ph) { a.lo = ph; a.hi = ph + 1; void* kargs[] = {&a};
        hipLaunchCooperativeKernel((const void*)mk_fwd, dim3(grid), dim3(NTHR), kargs, LDS_BYTES, stream); }
#else
    a.lo = 0; a.hi = NPHASES;
    void* kargs[] = {&a};
    hipError_t e = hipLaunchCooperativeKernel((const void*)mk_fwd, dim3(grid), dim3(NTHR), kargs, LDS_BYTES, stream);
    if (e != hipSuccess) fprintf(stderr, "cooperative launch failed: %s (grid %d)\n", hipGetErrorString(e), grid);
#endif
}
```
